# Optimizing an MI355X kernel written in HIP

```python
import math
import jax, jax.numpy as jnp
from jax import lax
import numpy as np

D_MODEL = 4096
BATCH = 4
SEQ = 2048
DEPTH = 1
DEC_BATCH = 128
DEC_SEQ = 8
PAST_LEN = 8192
PAGE_SIZE = 128

HEAD_DIM = 128
ATTN_HEADS = D_MODEL // (2 * HEAD_DIM)
KV_HEADS = ATTN_HEADS // 4
Q_PER_KV = ATTN_HEADS // KV_HEADS
ATTN_WIDTH = ATTN_HEADS * HEAD_DIM
WINDOW = 128
BLOCK = 128
N_BUCKETS = 32
MAX_DISTANCE = 128
SSD_HEAD_DIM = 64
SSD_HEADS = D_MODEL // (2 * SSD_HEAD_DIM)
SSD_WIDTH = SSD_HEADS * SSD_HEAD_DIM
SSD_GROUPS = 8
HEADS_PER_GROUP = SSD_HEADS // SSD_GROUPS
SSD_STATE = 128
SSD_CONV = 4
SSD_CHUNK = 128
CONV_DIM = SSD_WIDTH + 2 * SSD_GROUPS * SSD_STATE
MIX_WIDTH = ATTN_WIDTH + SSD_WIDTH
IN_DIM = ATTN_WIDTH + 2 * KV_HEADS * HEAD_DIM + SSD_WIDTH + CONV_DIM + SSD_HEADS
D_FF = (8 * D_MODEL // 3 + 255) // 256 * 256
FFN_CONV = 3
EPS = 1e-6

kernel_name = "hymba_ssd_swa_convffn_step"


def _rms(x, w):
    xf = x.astype(jnp.float32)
    y = xf * lax.rsqrt(jnp.mean(xf * xf, axis=-1, keepdims=True) + EPS)
    return (y * w.astype(jnp.float32)).astype(x.dtype)


def _causal_dwconv(x, prev, w, b):
    K = w.shape[0]
    L = x.shape[1]
    xp = jnp.concatenate([prev.astype(x.dtype), x], axis=1)
    y = b + w[0] * xp[:, 0:L]
    for t in range(1, K):
        y = y + w[t] * xp[:, t:t + L]
    return y, xp[:, L:]


def _t5_bucket(dist):
    n = jnp.maximum(dist, 0)
    max_exact = N_BUCKETS // 2
    nf = jnp.maximum(n, 1).astype(jnp.float32)
    large = max_exact + (jnp.log(nf / max_exact) / math.log(MAX_DISTANCE / max_exact)
                         * (N_BUCKETS - max_exact)).astype(jnp.int32)
    large = jnp.minimum(large, N_BUCKETS - 1)
    return jnp.where(n < max_exact, n, large)


def _attend(q, k, v, dist, valid, sinks, rel_bias):
    n, lq, lk = dist.shape
    bias = rel_bias.astype(jnp.float32)[_t5_bucket(dist)].reshape(n, lq, lk, KV_HEADS, Q_PER_KV)
    bias = jnp.transpose(bias, (0, 3, 4, 1, 2))
    s = jnp.einsum("bnqhgd,bnshd->bnhgqs", q, k, preferred_element_type=jnp.float32)
    s = s * (HEAD_DIM ** -0.5) + bias[None]
    s = jnp.where(valid[None, :, None, None], s, -jnp.inf)
    sink = sinks.astype(jnp.float32).reshape(1, 1, KV_HEADS, Q_PER_KV, 1, 1)
    m = jnp.maximum(jnp.max(s, axis=-1, keepdims=True), sink)
    p = jnp.exp(s - m)
    probs = p / (jnp.sum(p, axis=-1, keepdims=True) + jnp.exp(sink - m))
    return jnp.einsum("bnhgqs,bnshd->bnqhgd", probs.astype(v.dtype), v)


def _attn_prompt(q, k, v, sinks, rel_bias):
    b, L = q.shape[:2]
    nb = L // BLOCK
    qb = q.reshape(b, nb, BLOCK, KV_HEADS, Q_PER_KV, HEAD_DIM)

    def band(t):
        cur = t.reshape(b, nb, BLOCK, KV_HEADS, HEAD_DIM)
        prev = jnp.concatenate([jnp.zeros_like(cur[:, :1]), cur[:, :-1]], axis=1)
        return jnp.concatenate([prev, cur], axis=2)

    i = jnp.arange(BLOCK)[:, None]
    j = jnp.arange(2 * BLOCK)[None, :]
    dist = (i + BLOCK - j)[None]
    kpos = jnp.arange(nb)[:, None, None] * BLOCK - BLOCK + j[None]
    valid = (dist >= 0) & (dist < WINDOW) & (kpos >= 0)
    o = _attend(qb, band(k), band(v), dist, valid, sinks, rel_bias)
    return o.reshape(b, L, ATTN_WIDTH)


def _attn_sample(q, k, v, win_k, win_v, sinks, rel_bias):
    b, L = q.shape[:2]
    keys = jnp.concatenate([win_k.astype(k.dtype), k], axis=1)
    vals = jnp.concatenate([win_v.astype(v.dtype), v], axis=1)
    i = jnp.arange(L)[:, None]
    j = jnp.arange(WINDOW + L)[None, :]
    dist = (i + WINDOW - j)[None]
    kpos = PAST_LEN - WINDOW + j
    valid = (dist >= 0) & (dist < WINDOW) & (kpos[None] >= 0)
    o = _attend(q.reshape(b, 1, L, KV_HEADS, Q_PER_KV, HEAD_DIM), keys[:, None], vals[:, None],
                dist, valid, sinks, rel_bias)
    return o.reshape(b, L, ATTN_WIDTH), keys[:, -WINDOW:], vals[:, -WINDOW:]


def _ssd(x, dt, A, Bm, Cm, h0):
    b, L = x.shape[:2]
    Q = SSD_CHUNK if L % SSD_CHUNK == 0 else L
    nc = L // Q
    G, Hg, P, N = SSD_GROUPS, HEADS_PER_GROUP, SSD_HEAD_DIM, SSD_STATE
    xc = x.reshape(b, nc, Q, G, Hg, P)
    dtc = dt.reshape(b, nc, Q, G, Hg)
    Bc = Bm.reshape(b, nc, Q, G, N)
    Cc = Cm.reshape(b, nc, Q, G, N)
    acs = jnp.cumsum(dtc * A.reshape(G, Hg), axis=2)
    xdt = xc * dtc[..., None]
    at = jnp.moveaxis(acs, 2, -1)
    seg = at[..., :, None] - at[..., None, :]
    causal = jnp.tril(jnp.ones((Q, Q), dtype=bool))
    Lmat = jnp.exp(jnp.where(causal, seg, -jnp.inf))
    cb = jnp.einsum("bclgn,bcsgn->bcgls", Cc, Bc)
    y_diag = jnp.einsum("bcgls,bcghls,bcsghp->bclghp", cb, Lmat, xdt)
    decay_end = jnp.exp(acs[:, :, -1:] - acs)
    st = jnp.einsum("bclgn,bclgh,bclghp->bcghpn", Bc, decay_end, xdt)
    chunk_decay = jnp.exp(acs[:, :, -1])

    def step(h, inp):
        s_c, d_c = inp
        return d_c[..., None, None] * h + s_c, h

    hT, h_in = lax.scan(step, h0.reshape(b, G, Hg, P, N),
                        (jnp.moveaxis(st, 1, 0), jnp.moveaxis(chunk_decay, 1, 0)))
    h_in = jnp.moveaxis(h_in, 0, 1)
    y_off = jnp.einsum("bclgn,bcghpn,bclgh->bclghp", Cc, h_in, jnp.exp(acs))
    y = (y_diag + y_off).reshape(b, L, SSD_HEADS, P)
    return y, hT.reshape(b, SSD_HEADS, P, N)


def _layer(x, win_k, win_v, ssm_h, ssd_prev, ffn_prev, rel_bias,
           mix_norm_w, w_in, q_norm_w, k_norm_w, attn_sinks, ssd_conv_w, ssd_conv_b,
           ssd_dt_bias, ssd_A_log, ssd_D, ssd_norm_w, w_out,
           ffn_norm_w, w_gate, w_up, ffn_conv_w, ffn_conv_b, w_down):
    b, L, _ = x.shape
    h = _rms(x, mix_norm_w)
    proj = h @ w_in
    offs = np.cumsum([ATTN_WIDTH, KV_HEADS * HEAD_DIM, KV_HEADS * HEAD_DIM, SSD_WIDTH, CONV_DIM])
    q, k, v, z, xbc, dt = jnp.split(proj, [int(o) for o in offs], axis=-1)

    q = _rms(q.reshape(b, L, ATTN_HEADS, HEAD_DIM), q_norm_w)
    k = _rms(k.reshape(b, L, KV_HEADS, HEAD_DIM), k_norm_w)
    v = v.reshape(b, L, KV_HEADS, HEAD_DIM)
    if win_k is None:
        attn = _attn_prompt(q, k, v, attn_sinks, rel_bias)
        new_k, new_v = k[:, -WINDOW:], v[:, -WINDOW:]
    else:
        attn, new_k, new_v = _attn_sample(q, k, v, win_k, win_v, attn_sinks, rel_bias)

    xbc_c, new_conv = _causal_dwconv(xbc, ssd_prev, ssd_conv_w, ssd_conv_b)
    xbc_c = jax.nn.silu(xbc_c).astype(jnp.float32)
    xs, Bm, Cm = jnp.split(xbc_c, [SSD_WIDTH, SSD_WIDTH + SSD_GROUPS * SSD_STATE], axis=-1)
    xs = xs.reshape(b, L, SSD_HEADS, SSD_HEAD_DIM)
    dtv = jax.nn.softplus(dt.astype(jnp.float32) + ssd_dt_bias.astype(jnp.float32))
    A = -jnp.exp(ssd_A_log.astype(jnp.float32))
    y, hT = _ssd(xs, dtv, A, Bm.reshape(b, L, SSD_GROUPS, SSD_STATE),
                 Cm.reshape(b, L, SSD_GROUPS, SSD_STATE), ssm_h.astype(jnp.float32))
    y = (y + ssd_D.astype(jnp.float32)[:, None] * xs).reshape(b, L, SSD_WIDTH)
    y = _rms(y * jax.nn.silu(z.astype(jnp.float32)), ssd_norm_w).astype(x.dtype)

    x = x + jnp.concatenate([attn.astype(x.dtype), y], axis=-1) @ w_out

    h2 = _rms(x, ffn_norm_w)
    g = h2 @ w_gate
    u = h2 @ w_up
    gc, new_ffn = _causal_dwconv(g, ffn_prev, ffn_conv_w, ffn_conv_b)
    x = x + (jax.nn.silu(gc) * u) @ w_down
    return x, new_k, new_v, hT.astype(x.dtype), new_conv, new_ffn


def setup_inputs(seed: int = 0) -> dict:
    key = jax.random.key(seed)
    ks = jax.random.split(key, 32)
    f32 = jnp.float32
    nrm = lambda k, shape, s=1.0: (jax.random.normal(k, shape, f32) * s)
    dt0 = jnp.exp(jax.random.uniform(ks[20], (DEPTH, SSD_HEADS), f32) * (math.log(0.1) - math.log(0.001))
                  + math.log(0.001))
    return {
        "x_prompt": nrm(ks[0], (BATCH, SEQ, D_MODEL)),
        "x_sample": nrm(ks[1], (DEC_BATCH, DEC_SEQ, D_MODEL)),
        "state_attn_k": nrm(ks[2], (DEPTH, DEC_BATCH, WINDOW, KV_HEADS, HEAD_DIM)),
        "state_attn_v": nrm(ks[3], (DEPTH, DEC_BATCH, WINDOW, KV_HEADS, HEAD_DIM)),
        "state_ssm": nrm(ks[4], (DEPTH, DEC_BATCH, SSD_HEADS, SSD_HEAD_DIM, SSD_STATE), 0.5),
        "state_ssd_conv": nrm(ks[5], (DEPTH, DEC_BATCH, SSD_CONV - 1, CONV_DIM)),
        "state_ffn_conv": nrm(ks[6], (DEPTH, DEC_BATCH, FFN_CONV - 1, D_FF)),
        "rel_bias": nrm(ks[7], (N_BUCKETS, ATTN_HEADS), 0.5),
        "mix_norm_w": 1.0 + nrm(ks[8], (DEPTH, D_MODEL), 0.02),
        "w_in": nrm(ks[9], (DEPTH, D_MODEL, IN_DIM), D_MODEL ** -0.5),
        "q_norm_w": 1.0 + nrm(ks[10], (DEPTH, HEAD_DIM), 0.02),
        "k_norm_w": 1.0 + nrm(ks[11], (DEPTH, HEAD_DIM), 0.02),
        "attn_sinks": nrm(ks[12], (DEPTH, ATTN_HEADS), 0.5),
        "ssd_conv_w": nrm(ks[13], (DEPTH, SSD_CONV, CONV_DIM), SSD_CONV ** -0.5),
        "ssd_conv_b": nrm(ks[14], (DEPTH, CONV_DIM), 0.01),
        "ssd_dt_bias": dt0 + jnp.log(-jnp.expm1(-dt0)),
        "ssd_A_log": jnp.log(jax.random.uniform(ks[15], (DEPTH, SSD_HEADS), f32, 1.0, 16.0)),
        "ssd_D": 1.0 + nrm(ks[16], (DEPTH, SSD_HEADS), 0.1),
        "ssd_norm_w": 1.0 + nrm(ks[17], (DEPTH, SSD_WIDTH), 0.02),
        "w_out": nrm(ks[18], (DEPTH, MIX_WIDTH, D_MODEL), MIX_WIDTH ** -0.5),
        "ffn_norm_w": 1.0 + nrm(ks[19], (DEPTH, D_MODEL), 0.02),
        "w_gate": nrm(ks[21], (DEPTH, D_MODEL, D_FF), D_MODEL ** -0.5),
        "w_up": nrm(ks[22], (DEPTH, D_MODEL, D_FF), D_MODEL ** -0.5),
        "ffn_conv_w": nrm(ks[23], (DEPTH, FFN_CONV, D_FF), FFN_CONV ** -0.5),
        "ffn_conv_b": nrm(ks[24], (DEPTH, D_FF), 0.01),
        "w_down": nrm(ks[25], (DEPTH, D_FF, D_MODEL), D_FF ** -0.5),
    }


def reference(x_prompt, x_sample, state_attn_k, state_attn_v, state_ssm, state_ssd_conv, state_ffn_conv,
              rel_bias, mix_norm_w, w_in, q_norm_w, k_norm_w, attn_sinks, ssd_conv_w, ssd_conv_b,
              ssd_dt_bias, ssd_A_log, ssd_D, ssd_norm_w, w_out, ffn_norm_w, w_gate, w_up,
              ffn_conv_w, ffn_conv_b, w_down):
    yp, ys = x_prompt, x_sample
    bp = x_prompt.shape[0]
    outs_p, outs_s = [], []
    for l in range(DEPTH):
        lw = (mix_norm_w[l], w_in[l], q_norm_w[l], k_norm_w[l], attn_sinks[l], ssd_conv_w[l], ssd_conv_b[l],
              ssd_dt_bias[l], ssd_A_log[l], ssd_D[l], ssd_norm_w[l], w_out[l],
              ffn_norm_w[l], w_gate[l], w_up[l], ffn_conv_w[l], ffn_conv_b[l], w_down[l])
        h0 = jnp.zeros((bp, SSD_HEADS, SSD_HEAD_DIM, SSD_STATE), jnp.float32)
        c0 = jnp.zeros((bp, SSD_CONV - 1, CONV_DIM), yp.dtype)
        f0 = jnp.zeros((bp, FFN_CONV - 1, D_FF), yp.dtype)
        yp, *sp = _layer(yp, None, None, h0, c0, f0, rel_bias, *lw)
        ys, *ss = _layer(ys, state_attn_k[l], state_attn_v[l], state_ssm[l], state_ssd_conv[l],
                         state_ffn_conv[l], rel_bias, *lw)
        outs_p.append(sp)
        outs_s.append(ss)
    p_k = jnp.stack([o[0] for o in outs_p])
    p_v = jnp.stack([o[1] for o in outs_p])
    p_ssm = jnp.stack([o[2] for o in outs_p])
    p_conv = jnp.stack([o[3] for o in outs_p])
    p_ffn = jnp.stack([o[4] for o in outs_p])
    s_k = jnp.stack([o[0] for o in outs_s])
    s_v = jnp.stack([o[1] for o in outs_s])
    s_ssm = jnp.stack([o[2] for o in outs_s])
    s_conv = jnp.stack([o[3] for o in outs_s])
    s_ffn = jnp.stack([o[4] for o in outs_s])
    return (yp, ys, p_k, p_v, p_ssm, p_conv, p_ffn, s_k, s_v, s_ssm, s_conv, s_ffn)
```

```cpp
#include <hip/hip_runtime.h>
#include <cstdio>
#include <cstdint>
namespace pg8 {
#define PG8_LAS __attribute__((address_space(3)))
typedef unsigned short bf16_t;
typedef short bf16x8 __attribute__((ext_vector_type(8)));
typedef float f32x4 __attribute__((ext_vector_type(4)));
typedef unsigned u32x4 __attribute__((ext_vector_type(4)));
constexpr int BM = 256, BK = 64, HALF = 128, HTB = HALF * BK * 2  , STAGE_BYTES = 8 * HTB, NXCD = 8, WGM = 8;

__host__ __device__ __forceinline__ int lds_byte(int r, int c) { const int st = (r >> 4) * 2 + (c >> 5), rr = r & 15, cc = c & 31, ob = rr * 64 + cc * 2; return st * 1024 + (ob ^ (((ob >> 9) & 1) << 5)); }
__host__ __device__ __forceinline__ void stage_rc(int b, int& R, int& C) { const int st = b / 1024, sb = b % 1024, swz = sb ^ (((sb >> 9) & 1) << 5); R = (st >> 1) * 16 + swz / 64; C = (st & 1) * 32 + (swz % 64) / 2; }
__host__ __device__ __forceinline__ int perm32(int rho) { const int n = rho >> 4, i = rho & 15; return 8 * (i >> 2) + 4 * n + (i & 3); }

struct Unit { int pm, pn; };
struct Gemm { const bf16_t* A; const bf16_t* Bt; int M, N, K; };

struct StaticOrder {
    int nM, nN, nwg, G, c;
    __host__ __device__ void init(int M, int N, int G_, int c_) { nM = M / BM; nN = N / BM; nwg = nM * nN; G = G_; c = c_; }
    __host__ __device__ bool next(int i, Unit& u) const {
        const long L = (long)i * G + c; if (L >= nwg) return false;
        int wgid = (int)L; { const int q = nwg / NXCD, r = nwg % NXCD, xcd = wgid % NXCD, off = wgid / NXCD; wgid = (xcd < r ? xcd * (q + 1) : r * (q + 1) + (xcd - r) * q) + off; }
        const int nig = WGM * nN, gid = wgid / nig, fm = gid * WGM, gsz = (nM - fm) < WGM ? (nM - fm) : WGM;
        u.pm = fm + ((wgid % nig) % gsz); u.pn = (wgid % nig) / gsz; return true;
    }
    __device__ __forceinline__ void a_ready(const Unit&) const {}
    __device__ __forceinline__ void done(const Unit&) const {}
};

__device__ __forceinline__ unsigned cvt_pk_bf16(float lo, float hi) { unsigned r; asm volatile("v_cvt_pk_bf16_f32 %0, %1, %2" : "=v"(r) : "v"(lo), "v"(hi)); return r; }
typedef float f32x2 __attribute__((ext_vector_type(2)));

struct EpiStoreBf16 {
    static constexpr bool PERM = true, AFTER_DRAIN = false;
    bf16_t* O; int ldc;
    __device__ __forceinline__ void operator()(const f32x4 (&acc)[2][2][4][2], const Unit& u, int wr, int wc, int fr, int fq) const {
        const int row0 = u.pm * BM + wr * 64 + fr; const int col0 = u.pn * BM + wc * 32 + 8 * fq;
#pragma unroll
        for (int ai = 0; ai < 2; ++ai)
#pragma unroll
            for (int m = 0; m < 4; ++m) { bf16_t* rowp = O + (size_t)(row0 + ai * HALF + m * 16) * ldc + col0;
#pragma unroll
                for (int bj = 0; bj < 2; ++bj) { const f32x4 v0 = acc[ai][bj][m][0], v1 = acc[ai][bj][m][1];
                    u32x4 w; w.x = cvt_pk_bf16(v0[0], v0[1]); w.y = cvt_pk_bf16(v0[2], v0[3]); w.z = cvt_pk_bf16(v1[0], v1[1]); w.w = cvt_pk_bf16(v1[2], v1[3]);
                    *(u32x4*)(rowp + bj * HALF) = w; } }
    }
};
struct EpiResF32 {
    static constexpr bool PERM = false, AFTER_DRAIN = false;
    const float* base0; const float* base1; int split_row; float* out; int ldc;
    __device__ __forceinline__ void operator()(const f32x4 (&acc)[2][2][4][2], const Unit& u, int wr, int wc, int fr, int fq) const {
        const int row0 = u.pm * BM + wr * 64 + fr; const int col0 = u.pn * BM + wc * 32 + 4 * fq;
        const float* base = (u.pm * BM >= split_row) ? (base1 - (size_t)split_row * ldc) : base0;
#pragma unroll
        for (int ai = 0; ai < 2; ++ai)
#pragma unroll
            for (int m = 0; m < 4; ++m) { const size_t off = (size_t)(row0 + ai * HALF + m * 16) * ldc + col0;
#pragma unroll
                for (int bj = 0; bj < 2; ++bj)
#pragma unroll
                    for (int n = 0; n < 2; ++n) { const f32x4 b = *(const f32x4*)(base + off + bj * HALF + n * 16); *(f32x4*)(out + off + bj * HALF + n * 16) = b + acc[ai][bj][m][n]; }
                if (m & 1) asm volatile("" ::: "memory"); }
    }
};
template <class Epi, class Sched, bool ALIGN_EPI = false, bool SP2 = false>
__device__ __forceinline__ void gemm_phase(PG8_LAS unsigned char* lds, const Gemm g, const Sched& S, const Epi& E) {
    const int tid = threadIdx.x, wid = __builtin_amdgcn_readfirstlane(tid >> 6), lane = tid & 63, wr = wid >> 2, wc = wid & 3, fr = lane & 15, fq = lane >> 4;
    const int K = g.K, nt = K / BK;
    unsigned voffA[2], voffB[2];
#pragma unroll
    for (int i = 0; i < 2; ++i) { int R, C; stage_rc(tid * 16 + i * 8192, R, C); const int Rb = Epi::PERM ? ((R & ~31) + perm32(R & 31)) : R;
        voffA[i] = (unsigned)(R * K + C) * 2u; voffB[i] = (unsigned)(Rb * K + C) * 2u; }
    const size_t kstep = (size_t)(BK * 2);
    const size_t hstep = (size_t)HALF * K * 2;
    const size_t tstep = 2 * hstep;
    const unsigned ldsw = (unsigned)wid * 1024u;
    const int aoff = lds_byte(wr * 64 + fr, fq * 8), boff = lds_byte(wc * 32 + fr, fq * 8);
#define PG8_SA(b, h) (((b) * 2 + (h)) * HTB)
#define PG8_SB(b, h) ((4 + (b) * 2 + (h)) * HTB)
#define PG8_STAGE(bufoff, gbase, voff) do { _Pragma("unroll") for (int _i = 0; _i < 2; ++_i) \
        __builtin_amdgcn_global_load_lds((const unsigned*)((const char*)(gbase) + (voff)[_i]), (PG8_LAS unsigned*)(lds + (bufoff) + ldsw + _i * 8192), 16, 0, 0); } while (0)
#define PG8_LDA(dst, b, h) do { _Pragma("unroll") for (int m = 0; m < 4; ++m) _Pragma("unroll") for (int k = 0; k < 2; ++k) dst[m][k] = *(const PG8_LAS bf16x8*)(lds + PG8_SA(b, h) + aoff + m * 2048 + k * 1024); } while (0)
#define PG8_LDB(dst, b, h) do { _Pragma("unroll") for (int n = 0; n < 2; ++n) _Pragma("unroll") for (int k = 0; k < 2; ++k) dst[n][k] = *(const PG8_LAS bf16x8*)(lds + PG8_SB(b, h) + boff + n * 2048 + k * 1024); } while (0)
#define PG8_MMA(ai, bj, At, Bt) do { __builtin_amdgcn_s_setprio(1); _Pragma("unroll") for (int m = 0; m < 4; ++m) _Pragma("unroll") for (int n = 0; n < 2; ++n) _Pragma("unroll") for (int k = 0; k < 2; ++k) \
        acc[ai][bj][m][n] = __builtin_amdgcn_mfma_f32_16x16x32_bf16(Bt[n][k], At[m][k], acc[ai][bj][m][n], 0, 0, 0); __builtin_amdgcn_s_setprio(0); } while (0)
#define PG8_WAIT_V(n) asm volatile("s_waitcnt vmcnt(" #n ")" ::: "memory")
#define PG8_WAIT_L(n) asm volatile("s_waitcnt lgkmcnt(" #n ")" ::: "memory")
#define PG8_BAR __builtin_amdgcn_s_barrier()
#define PG8_SCHED __builtin_amdgcn_sched_barrier(0)
    Unit cur, nxt; int ui = 0;
    if (!S.next(0, cur)) return;
    f32x4 acc[2][2][4][2];
#pragma unroll
    for (int a = 0; a < 2; ++a)
#pragma unroll
        for (int b = 0; b < 2; ++b)
#pragma unroll
            for (int m = 0; m < 4; ++m)
#pragma unroll
                for (int n = 0; n < 2; ++n) acc[a][b][m][n] = (f32x4){0.f, 0.f, 0.f, 0.f};
    bf16x8 At[4][2], B0[2][2], B1[2][2];
    const char* cA = (const char*)g.A + (size_t)cur.pm * tstep; const char* cB = (const char*)g.Bt + (size_t)cur.pn * tstep;
    S.a_ready(cur);
    if constexpr (SP2) {
        PG8_STAGE(PG8_SB(0, 0), cB, voffB); PG8_STAGE(PG8_SB(0, 1), cB + hstep, voffB); PG8_STAGE(PG8_SA(0, 0), cA, voffA); PG8_STAGE(PG8_SA(0, 1), cA + hstep, voffA);
        if (wr == 1) PG8_BAR;
        PG8_WAIT_V(2); PG8_BAR;
        PG8_STAGE(PG8_SB(1, 0), cB + kstep, voffB); PG8_STAGE(PG8_SA(1, 0), cA + kstep, voffA); PG8_STAGE(PG8_SB(1, 1), cB + hstep + kstep, voffB);
        PG8_WAIT_V(6); PG8_BAR;
    } else {
        PG8_STAGE(PG8_SB(0, 0), cB, voffB); PG8_STAGE(PG8_SA(0, 0), cA, voffA); PG8_STAGE(PG8_SB(0, 1), cB + hstep, voffB); PG8_STAGE(PG8_SA(0, 1), cA + hstep, voffA);
        if (wr == 1) PG8_BAR;
        PG8_WAIT_V(4); PG8_BAR;
        PG8_STAGE(PG8_SB(1, 0), cB + kstep, voffB); PG8_STAGE(PG8_SA(1, 0), cA + kstep, voffA); PG8_STAGE(PG8_SB(1, 1), cB + hstep + kstep, voffB);
        PG8_WAIT_V(6); PG8_BAR;
    }
    for (;;) {
        const bool has_next = S.next(ui + 1, nxt);
        const char* nA = has_next ? (const char*)g.A + (size_t)nxt.pm * tstep : cA; const char* nB = has_next ? (const char*)g.Bt + (size_t)nxt.pn * tstep : cB;
        for (int t = 0; t < nt; t += 2) {
            const bool last = (t == nt - 2);
            const char* a1 = cA + (size_t)(t + 1) * kstep;
            const char* a2 = last ? nA : cA + (size_t)(t + 2) * kstep; const char* b2 = last ? nB : cB + (size_t)(t + 2) * kstep;
            const char* a3 = a2 + kstep; const char* b3 = b2 + kstep;
            if (last && has_next) S.a_ready(nxt);
            if constexpr (SP2) {
            PG8_LDB(B0, 0, 0); PG8_LDB(B1, 0, 1); PG8_SCHED; PG8_LDA(At, 0, 0); PG8_STAGE(PG8_SA(1, 1), a1 + hstep, voffA);
            PG8_WAIT_V(8); PG8_WAIT_L(0); PG8_BAR; PG8_MMA(0, 0, At, B0); PG8_MMA(0, 1, At, B1); PG8_BAR; PG8_SCHED;
            PG8_LDA(At, 0, 1); PG8_STAGE(PG8_SB(0, 0), b2, voffB); PG8_STAGE(PG8_SB(0, 1), b2 + hstep, voffB); PG8_STAGE(PG8_SA(0, 0), a2, voffA);
            PG8_WAIT_V(8); PG8_WAIT_L(0); PG8_BAR; PG8_MMA(1, 0, At, B0); PG8_MMA(1, 1, At, B1); PG8_BAR; PG8_SCHED;
            PG8_LDB(B0, 1, 0); PG8_LDB(B1, 1, 1); PG8_SCHED; PG8_LDA(At, 1, 0); PG8_STAGE(PG8_SA(0, 1), a2 + hstep, voffA);
            PG8_WAIT_V(8); PG8_WAIT_L(0); PG8_BAR; PG8_MMA(0, 0, At, B0); PG8_MMA(0, 1, At, B1); PG8_BAR; PG8_SCHED;
            PG8_LDA(At, 1, 1); PG8_STAGE(PG8_SB(1, 0), b3, voffB); PG8_STAGE(PG8_SB(1, 1), b3 + hstep, voffB); PG8_STAGE(PG8_SA(1, 0), a3, voffA);
            PG8_WAIT_V(8); PG8_WAIT_L(0); PG8_BAR; PG8_MMA(1, 0, At, B0); PG8_MMA(1, 1, At, B1); PG8_BAR; PG8_SCHED;
            } else {
            PG8_LDB(B0, 0, 0); PG8_SCHED; PG8_LDA(At, 0, 0); PG8_STAGE(PG8_SA(1, 1), a1 + hstep, voffA);
            PG8_WAIT_L(8); PG8_BAR; PG8_WAIT_L(0); PG8_MMA(0, 0, At, B0); PG8_BAR; PG8_SCHED;
            PG8_LDB(B1, 0, 1); PG8_STAGE(PG8_SB(0, 0), b2, voffB);
            PG8_BAR; PG8_WAIT_L(0); PG8_MMA(0, 1, At, B1); PG8_BAR;
            PG8_LDA(At, 0, 1); PG8_STAGE(PG8_SA(0, 0), a2, voffA);
            PG8_BAR; PG8_WAIT_L(0); PG8_MMA(1, 0, At, B0); PG8_BAR; PG8_SCHED;
            PG8_STAGE(PG8_SB(0, 1), b2 + hstep, voffB);
            PG8_WAIT_V(6); PG8_BAR; PG8_MMA(1, 1, At, B1); PG8_BAR;
            PG8_LDB(B0, 1, 0); PG8_SCHED; PG8_LDA(At, 1, 0); PG8_STAGE(PG8_SA(0, 1), a2 + hstep, voffA);
            PG8_WAIT_L(8); PG8_BAR; PG8_WAIT_L(0); PG8_MMA(0, 0, At, B0); PG8_BAR; PG8_SCHED;
            PG8_LDB(B1, 1, 1); PG8_STAGE(PG8_SB(1, 0), b3, voffB);
            PG8_BAR; PG8_WAIT_L(0); PG8_MMA(0, 1, At, B1); PG8_BAR;
            PG8_LDA(At, 1, 1); PG8_STAGE(PG8_SA(1, 0), a3, voffA);
            PG8_BAR; PG8_WAIT_L(0); PG8_MMA(1, 0, At, B0); PG8_BAR; PG8_SCHED;
            PG8_STAGE(PG8_SB(1, 1), b3 + hstep, voffB);
            PG8_WAIT_V(6); PG8_BAR; PG8_MMA(1, 1, At, B1); PG8_BAR;
            }
        }
        if constexpr (ALIGN_EPI) { if (wr == 0) PG8_BAR; }
        if constexpr (!Epi::AFTER_DRAIN) { E(acc, cur, wr, wc, fr, fq); S.done(cur); }
        if (!has_next) break;
#pragma unroll
        for (int a = 0; a < 2; ++a)
#pragma unroll
            for (int b = 0; b < 2; ++b)
#pragma unroll
                for (int m = 0; m < 4; ++m)
#pragma unroll
                    for (int n = 0; n < 2; ++n) acc[a][b][m][n] = (f32x4){0.f, 0.f, 0.f, 0.f};
        cur = nxt; cA = nA; cB = nB; ++ui;
        if constexpr (ALIGN_EPI) { if (wr == 1) PG8_BAR; }
    }
    PG8_WAIT_V(0);
    if constexpr (!ALIGN_EPI) { if (wr == 0) PG8_BAR; }
    PG8_BAR;
    if constexpr (Epi::AFTER_DRAIN) { E.fused(acc, cur, wr, wc, fr, fq, lds, wid, lane); S.done(cur); }
#undef PG8_SA
#undef PG8_SB
#undef PG8_STAGE
#undef PG8_LDA
#undef PG8_LDB
#undef PG8_MMA
#undef PG8_WAIT_V
#undef PG8_WAIT_L
#undef PG8_BAR
#undef PG8_SCHED
}
}
#ifndef PG8_SP2
#define PG8_SP2 true
#endif
#ifndef PG8_ALIGN
#define PG8_ALIGN true
#endif
#ifndef MK_N_LAUNCHES
#define MK_N_LAUNCHES 1
#endif
constexpr int N_LAUNCHES = MK_N_LAUNCHES;
constexpr int N_PHASES = 9;
constexpr int NWAVES = 8;

constexpr int DM = 4096, SEQ = 2048, NBP = 4, MP = NBP * SEQ, NBS = 128, LS = 8, MS = NBS * LS, M = MP + MS;
constexpr int C_Q = 0, C_K = 2048, C_V = 2560, C_Z = 3072, C_X = 5120, C_DT = 9216, LDP = 9472;
constexpr int DFF = 11008, NGU = 2 * DFF;
constexpr float EPS = 1e-6f, LOG2E = 1.4426950408889634f;

constexpr size_t O_YP = 0, O_YS = 33554432, O_PK = 37748736, O_PV = 38010880, O_PSSM = 38273024, O_PCONV = 39321600, O_PFFN = 39370752,
                 O_SK = 39458816, O_SV = 47847424, O_SSSM = 56236032, O_SCONV = 89790464, O_SFFN = 91363328, O_END = 94181376;

constexpr size_t MiB = 1u << 20;
constexpr size_t WS_CTL = 0, CTL_ZERO_BYTES = 1 * MiB;
constexpr size_t WS_W3 = 2 * MiB;
constexpr size_t WS_W4 = 174 * MiB;
constexpr size_t WS_XN = 260 * MiB;
constexpr size_t WS_W1 = 332 * MiB;
constexpr size_t WS_W2 = 406 * MiB;
constexpr size_t WS_PROJ = 438 * MiB;
constexpr size_t WS_MIX = 605 * MiB;
constexpr size_t WS_GU = 332 * MiB;
constexpr size_t WS_ACT = 719 * MiB;
constexpr size_t WS_END = 913 * MiB;
static_assert(WS_W3 + (size_t)NGU * DM * 2 <= WS_W4 && WS_W4 + (size_t)DM * DFF * 2 <= WS_XN && WS_XN + (size_t)M * DM * 2 <= WS_W1 && WS_W1 + (size_t)LDP * DM * 2 <= WS_W2 &&
              WS_W2 + (size_t)DM * DM * 2 <= WS_PROJ && WS_PROJ + (size_t)M * LDP * 2 <= WS_MIX && WS_MIX + (size_t)M * DM * 2 <= WS_ACT && WS_GU + (size_t)M * NGU * 2 <= WS_ACT &&
              WS_ACT + (size_t)M * DFF * 2 <= WS_END, "d_ws map");

constexpr int CW_TMO = 0, CW_CODE = 1, CW_BAR = 4096, CW_Q = 8192  , CW_SSQ = 16384  ;

constexpr int RING_OFF = 0, RING_BYTES = 131072;
constexpr int TB_OFF = 131072;
constexpr int CWL_OFF = TB_OFF + 8192;
constexpr int LDSCTL_OFF = CWL_OFF + 6400, MISC_OFF = LDSCTL_OFF + 320;
constexpr int LDS_BYTES = 147456;
static_assert(MISC_OFF + 128 <= LDS_BYTES && (MISC_OFF % 16) == 0, "LDS map");

#define GAS __attribute__((address_space(1)))
#define LAS __attribute__((address_space(3)))
typedef unsigned short bf16;
typedef unsigned u32x4 __attribute__((ext_vector_type(4)));
typedef unsigned u32x2 __attribute__((ext_vector_type(2)));
typedef float f32x4 __attribute__((ext_vector_type(4)));
typedef float f32x16 __attribute__((ext_vector_type(16)));
typedef short bf16x8 __attribute__((ext_vector_type(8)));
typedef short s16x4 __attribute__((ext_vector_type(4)));
typedef short v4i16_t __attribute__((ext_vector_type(4)));
typedef GAS unsigned gu32;
#define RLX_AGENT __ATOMIC_RELAXED, __HIP_MEMORY_SCOPE_AGENT
#define LDS_WAIT() asm volatile("s_waitcnt lgkmcnt(0)" ::: "memory")
#define VM_WAIT() asm volatile("s_waitcnt vmcnt(0)" ::: "memory")
#define MFMA32(a, b, c) __builtin_amdgcn_mfma_f32_32x32x16_bf16((a), (b), (c), 0, 0, 0)
typedef float f32x2_t __attribute__((ext_vector_type(2)));
typedef __bf16 bf16x2_t __attribute__((ext_vector_type(2)));
__device__ __forceinline__ unsigned cvtpk(float lo, float hi) { f32x2_t v = {lo, hi}; bf16x2_t b = __builtin_convertvector(v, bf16x2_t); return __builtin_bit_cast(unsigned, b); }
__device__ __forceinline__ float bf2f(unsigned short h) { return __uint_as_float((unsigned)h << 16); }
__device__ __forceinline__ float bflo(unsigned w) { return __uint_as_float(w << 16); }
__device__ __forceinline__ float bfhi(unsigned w) { return __uint_as_float(w & 0xffff0000u); }
__device__ __forceinline__ void unpack8(const u32x4 w, float (&f)[8]) { f[0] = bflo(w.x); f[1] = bfhi(w.x); f[2] = bflo(w.y); f[3] = bfhi(w.y); f[4] = bflo(w.z); f[5] = bfhi(w.z); f[6] = bflo(w.w); f[7] = bfhi(w.w); }
__device__ __forceinline__ u32x4 pack8(const float (&f)[8]) { u32x4 w; w.x = cvtpk(f[0], f[1]); w.y = cvtpk(f[2], f[3]); w.z = cvtpk(f[4], f[5]); w.w = cvtpk(f[6], f[7]); return w; }
__device__ __forceinline__ float silu_f(float x) { return x * __builtin_amdgcn_rcpf(1.0f + __expf(-x)); }
__device__ __forceinline__ float softplus_f(float x) { return x > 20.f ? x : log1pf(__expf(x)); }
__device__ __forceinline__ int crow(int r, int hi) { return (r & 3) + 8 * (r >> 2) + 4 * hi; }
__device__ __forceinline__ s16x4 vtr(const LAS unsigned char* p) { return __builtin_bit_cast(s16x4, __builtin_amdgcn_ds_read_tr16_b64_v4i16((LAS v4i16_t*)p)); }
__device__ __forceinline__ bf16x8 cat4(s16x4 a, s16x4 b) { bf16x8 r; r[0] = a[0]; r[1] = a[1]; r[2] = a[2]; r[3] = a[3]; r[4] = b[0]; r[5] = b[1]; r[6] = b[2]; r[7] = b[3]; return r; }
__device__ __forceinline__ bf16x8 pack_step(const f32x16& x, int s) {
    u32x4 p; p.x = cvtpk(x[8 * s], x[8 * s + 1]); p.y = cvtpk(x[8 * s + 2], x[8 * s + 3]); p.z = cvtpk(x[8 * s + 4], x[8 * s + 5]); p.w = cvtpk(x[8 * s + 6], x[8 * s + 7]);
    return __builtin_bit_cast(bf16x8, p);
}
__device__ __forceinline__ float wave_sum(float v) {
#pragma unroll
    for (int o = 1; o < 64; o <<= 1) v += __shfl_xor(v, o);
    return v;
}

struct Args { const float* in[26]; float* out; unsigned char* ws; int ph_lo, ph_hi, grid, pad; };
#define KARG ((const __attribute__((address_space(4))) Args*)__builtin_amdgcn_kernarg_segment_ptr())
#define P_x_prompt (KARG->in[0])
#define P_x_sample (KARG->in[1])
#define P_st_k (KARG->in[2])
#define P_st_v (KARG->in[3])
#define P_st_ssm (KARG->in[4])
#define P_st_conv (KARG->in[5])
#define P_st_ffn (KARG->in[6])
#define P_rel_bias (KARG->in[7])
#define P_mix_nw (KARG->in[8])
#define P_w_in (KARG->in[9])
#define P_q_nw (KARG->in[10])
#define P_k_nw (KARG->in[11])
#define P_sinks (KARG->in[12])
#define P_conv_w (KARG->in[13])
#define P_conv_b (KARG->in[14])
#define P_dt_bias (KARG->in[15])
#define P_A_log (KARG->in[16])
#define P_Dv (KARG->in[17])
#define P_ssd_nw (KARG->in[18])
#define P_w_out (KARG->in[19])
#define P_ffn_nw (KARG->in[20])
#define P_w_gate (KARG->in[21])
#define P_w_up (KARG->in[22])
#define P_fconv_w (KARG->in[23])
#define P_fconv_b (KARG->in[24])
#define P_w_down (KARG->in[25])
#define P_out (KARG->out)
#define P_ws (KARG->ws)
#define P_W1 ((bf16*)(P_ws + WS_W1))
#define P_W2 ((bf16*)(P_ws + WS_W2))
#define P_W3 ((bf16*)(P_ws + WS_W3))
#define P_W4 ((bf16*)(P_ws + WS_W4))
#define P_XN ((bf16*)(P_ws + WS_XN))
#define P_PROJ ((bf16*)(P_ws + WS_PROJ))
#define P_MIX ((bf16*)(P_ws + WS_MIX))
#define P_GU ((bf16*)(P_ws + WS_GU))
#define P_ACT ((bf16*)(P_ws + WS_ACT))
#define P_ctl ((gu32*)(P_ws + WS_CTL))
#define P_ssq ((float*)(P_ws + WS_CTL) + CW_SSQ)
struct Ptrs {};
#define XB_TMO      128
#define XB_XCNT(j)  (256  + 64 * (j))
#define XB_XSUB(j)  (1280 + 64 * (j))
#define XB_XGEN(j)  (2304 + 64 * (j))
#define XB_TOP      3328
#define XB_TOPGEN   3392
#define XCD_BAR_WORDS 3456
#define XB_SPIN_CAP (1u << 18)

__device__ __forceinline__ unsigned xb_ld(unsigned* p)              { return __hip_atomic_load(p, __ATOMIC_RELAXED, __HIP_MEMORY_SCOPE_AGENT); }
__device__ __forceinline__ unsigned xb_add(unsigned* p, unsigned v) { return __hip_atomic_fetch_add(p, v, __ATOMIC_RELAXED, __HIP_MEMORY_SCOPE_AGENT); }
__device__ __forceinline__ unsigned xb_xcc_id() { return (unsigned)__builtin_amdgcn_s_getreg((3 << 11) | 20) & 0xFu; }
#define XB_SPIN(cond, bar) do { unsigned _sp = 0; while (cond) { __builtin_amdgcn_s_sleep(1); \
    if ((++_sp & 255u) == 0u) { if (xb_ld(&(bar)[XB_TMO])) break; if (_sp > XB_SPIN_CAP) { atomicAdd(&(bar)[XB_TMO], 1u); break; } } } } while (0)

struct XcdBarrier {
    unsigned* bar; unsigned x;
    volatile LAS unsigned* st;
};

__device__ __forceinline__ XcdBarrier xcd_barrier_post(unsigned* bar, volatile LAS unsigned* st) {
    XcdBarrier b; b.bar = bar; b.x = xb_xcc_id(); b.st = st;
    if (threadIdx.x == 0) (void)xb_add(&bar[XB_XCNT(b.x)], 1u);
    return b;
}
__device__ __forceinline__ void xcd_barrier_complete(unsigned* bar, unsigned x, unsigned& nloc, unsigned& nx) {
    const unsigned G = (unsigned)KARG->grid;
    unsigned sum, cnt, mine, sp = 0u;
    for (;;) {
        sum = 0u; cnt = 0u; mine = 0u;
#pragma unroll
        for (unsigned j = 0; j < 16; ++j) { const unsigned c = xb_ld(&bar[XB_XCNT(j)]); sum += c; cnt += (c > 0u) ? 1u : 0u; mine = (j == x) ? c : mine; }
        if (sum == G) break;
        __builtin_amdgcn_s_sleep(1);
        if ((++sp & 255u) == 0u) { if (xb_ld(&bar[XB_TMO])) break; if (sp > XB_SPIN_CAP) { atomicAdd(&bar[XB_TMO], 1u); break; } }
    }
    nloc = mine > 0u ? mine : 1u; nx = cnt > 0u ? cnt : 1u;
}

__device__ __forceinline__ void xcd_barrier(const XcdBarrier& b) {
    asm volatile("s_waitcnt vmcnt(0)" ::: "memory");
    __syncthreads();
    if (threadIdx.x == 0) {
        unsigned* bar = b.bar;
        __builtin_amdgcn_s_waitcnt(0);
        unsigned nloc = b.st[0], nx = b.st[1];
        if (nloc == 0u) { xcd_barrier_complete(bar, b.x, nloc, nx); b.st[0] = nloc; b.st[1] = nx; }
        const unsigned old = xb_add(&bar[XB_XSUB(b.x)], 1u);
        const unsigned gen = old / nloc;
        if (old + 1u == (gen + 1u) * nloc) {
            __builtin_amdgcn_fence(__ATOMIC_RELEASE, "agent");
            asm volatile("s_waitcnt vmcnt(0)" ::: "memory");
            const unsigned og = xb_add(&bar[XB_TOP], 1u);
            const unsigned tg = og / nx;
            if (og + 1u == (tg + 1u) * nx) xb_add(&bar[XB_TOPGEN], 1u);
            else XB_SPIN(xb_ld(&bar[XB_TOPGEN]) == tg, bar);
            __builtin_amdgcn_fence(__ATOMIC_ACQUIRE, "agent");
            xb_add(&bar[XB_XGEN(b.x)], 1u);
            asm volatile("s_waitcnt vmcnt(0)" ::: "memory");
        } else {
            XB_SPIN(xb_ld(&bar[XB_XGEN(b.x)]) == gen, bar);
            __builtin_amdgcn_fence(__ATOMIC_ACQUIRE, "agent");
            asm volatile("s_waitcnt vmcnt(0)" ::: "memory");
        }
    }
    __syncthreads();
}


struct Frame { LAS unsigned char* lds; int tid, lane, wave, G, bid; };

__device__ __forceinline__ int wq_next(gu32* ctr, volatile LAS unsigned* slot, int tid) {
    __syncthreads();
    if (tid == 0) *slot = __hip_atomic_fetch_add(ctr, 1u, RLX_AGENT);
    __syncthreads();
    return (int)*slot;
}

__device__ __forceinline__ void p0_transpose_item(const float* W, int K, int N, bf16* WT, int mode, LAS float* scr, int item, int lane) {
    const int nblk = N / 32, kb = item / nblk, nb = item % nblk, k0 = 64 * kb, n0 = 32 * nb;
    const int rb = (mode == 0) ? n0 : ((n0 >> 7) * 256 + (n0 & 127) + (mode == 2 ? 128 : 0));
#pragma unroll 8
    for (int i = 0; i < 32; ++i) { const int kk = 2 * i + (lane >> 5); scr[kk * 33 + (lane & 31)] = W[(size_t)(k0 + kk) * N + n0 + (lane & 31)]; }
    LDS_WAIT(); asm volatile("" ::: "memory");
    const int c = lane & 7;
#pragma unroll
    for (int j = 0; j < 4; ++j) { const int n = (lane >> 3) + 8 * j; const LAS float* s = scr + (8 * c) * 33 + n;
        u32x4 o; o.x = cvtpk(s[0 * 33], s[1 * 33]); o.y = cvtpk(s[2 * 33], s[3 * 33]); o.z = cvtpk(s[4 * 33], s[5 * 33]); o.w = cvtpk(s[6 * 33], s[7 * 33]);
        *(u32x4*)(WT + (size_t)(rb + n) * K + k0 + 8 * c) = o; }
    LDS_WAIT(); asm volatile("" ::: "memory");
}
__device__ __forceinline__ void rms_row_to_bf16(const float* xrow, const float* w, bf16* orow, int lane) {
    const f32x4* xr = (const f32x4*)xrow + lane; f32x4 v[16]; float s = 0.f;
#pragma unroll
    for (int j = 0; j < 16; ++j) { v[j] = xr[64 * j]; s += (v[j].x * v[j].x + v[j].y * v[j].y) + (v[j].z * v[j].z + v[j].w * v[j].w); }
    const float rstd = 1.0f / sqrtf(wave_sum(s) * (1.0f / DM) + EPS);
    const f32x4* wr = (const f32x4*)w + lane; u32x2* o8 = (u32x2*)orow + lane;
#pragma unroll
    for (int j = 0; j < 16; ++j) { const f32x4 wv = wr[64 * j]; u32x2 o; o.x = cvtpk(v[j].x * rstd * wv.x, v[j].y * rstd * wv.y); o.y = cvtpk(v[j].z * rstd * wv.z, v[j].w * rstd * wv.w); o8[64 * j] = o; }
}
__device__ __forceinline__ void p0_prologue(const Frame& F, const Ptrs& P) {
    LAS float* scr = (LAS float*)(F.lds + RING_OFF + F.wave * 16384);
    const int gw = F.bid * NWAVES + F.wave, NGW = F.G * NWAVES;
    constexpr int I_1 = (DM / 64) * (9248 / 32), I_2 = (DM / 64) * (DM / 32), I_3 = (DM / 64) * (DFF / 32), I_4 = (DFF / 64) * (DM / 32);
    constexpr int NITEMS = I_1 + I_2 + 2 * I_3 + I_4;
    for (int it = gw; it < NITEMS; it += NGW) {
        int r = it;
        if (r < I_1) { p0_transpose_item(P_w_in, DM, 9248, P_W1, 0, scr, r, F.lane); continue; } r -= I_1;
        if (r < I_2) { p0_transpose_item(P_w_out, DM, DM, P_W2, 0, scr, r, F.lane); continue; } r -= I_2;
        if (r < I_3) { p0_transpose_item(P_w_gate, DM, DFF, P_W3, 1, scr, r, F.lane); continue; } r -= I_3;
        if (r < I_3) { p0_transpose_item(P_w_up, DM, DFF, P_W3, 2, scr, r, F.lane); continue; } r -= I_3;
        p0_transpose_item(P_w_down, DFF, DM, P_W4, 0, scr, r, F.lane);
    }
    for (int m = gw; m < M; m += NGW) { const float* xr = (m < MP) ? P_x_prompt + (size_t)m * DM : P_x_sample + (size_t)(m - MP) * DM; rms_row_to_bf16(xr, P_mix_nw, P_XN + (size_t)m * DM, F.lane); }
}

constexpr int KS = 272, VS = 320;
__device__ __forceinline__ int t5_bucket(int n) { if (n < 16) return n; const float v = logf((float)n / 16.0f) / 2.0794415f * 16.0f; const int l = 16 + (int)v; return l < 31 ? l : 31; }

__device__ __forceinline__ void attn_task(const LAS unsigned char* Kl, const LAS unsigned char* Vl, int kt0, const bf16x8 (&qf)[8], int d0, int jmin, const LAS float* tb, float sink2, bf16* outp, int lane) {
    const int q = lane & 31, hi = lane >> 5;
    asm volatile("" : "+v"(d0));
    f32x16 st[5];
#pragma unroll
    for (int t = 0; t < 5; ++t) {
        f32x16 a; for (int i = 0; i < 16; ++i) a[i] = 0.f;
        const LAS unsigned char* kp = Kl + ((kt0 + t) * 32 + q) * KS + hi * 16;
#pragma unroll
        for (int ks = 0; ks < 8; ++ks) a = MFMA32(*(const LAS bf16x8*)(kp + ks * 32), qf[ks], a);
        st[t] = a; __builtin_amdgcn_sched_barrier(0);
    }
    float mx = sink2;
#pragma unroll
    for (int t = 0; t < 5; ++t)
#pragma unroll
        for (int r = 0; r < 16; ++r) { const int jj = 32 * t + crow(r, hi); const int dist = d0 - jj; const bool ok = ((unsigned)dist < 128u) && (jj >= jmin);
            float bv = tb[dist & 127]; asm volatile("" : "+v"(bv)); const float s = ok ? st[t][r] + bv : -__builtin_inff(); st[t][r] = s; mx = fmaxf(mx, s); }
    mx = fmaxf(mx, __shfl_xor(mx, 32));
    float l = 0.f;
#pragma unroll
    for (int t = 0; t < 5; ++t)
#pragma unroll
        for (int r = 0; r < 16; ++r) { const float p = __builtin_amdgcn_exp2f(st[t][r] - mx); st[t][r] = p; l += p; }
    l += __shfl_xor(l, 32); l += __builtin_amdgcn_exp2f(sink2 - mx);
    const float inv = 1.0f / l;
    f32x16 ot[4];
#pragma unroll
    for (int d = 0; d < 4; ++d) for (int i = 0; i < 16; ++i) ot[d][i] = 0.f;
    const int g4 = lane >> 4, i16 = lane & 15;
    const LAS unsigned char* vp = Vl + (kt0 * 32 + 4 * hi + (i16 >> 2)) * VS + ((g4 & 1) * 16 + (i16 & 3) * 4) * 2;
#pragma unroll
    for (int t = 0; t < 5; ++t)
#pragma unroll
        for (int s2 = 0; s2 < 2; ++s2) { const bf16x8 pf = pack_step(st[t], s2);
#pragma unroll
            for (int d = 0; d < 4; ++d) { const LAS unsigned char* a = vp + (t * 32 + s2 * 16) * VS + d * 64; const bf16x8 vf = cat4(vtr(a), vtr(a + 8 * VS)); ot[d] = MFMA32(vf, pf, ot[d]); } __builtin_amdgcn_sched_barrier(0); }
#pragma unroll
    for (int d = 0; d < 4; ++d)
#pragma unroll
        for (int r4 = 0; r4 < 4; ++r4) { u32x2 w; w.x = cvtpk(ot[d][4 * r4] * inv, ot[d][4 * r4 + 1] * inv); w.y = cvtpk(ot[d][4 * r4 + 2] * inv, ot[d][4 * r4 + 3] * inv);
            *(u32x2*)(outp + 32 * d + 8 * r4 + 4 * hi) = w; }
}
__device__ __forceinline__ void load_q(const bf16* qp, const float* qnw, int hi, bf16x8 (&qf)[8]) {
    u32x4 qw[8]; float ss = 0.f;
#pragma unroll
    for (int ks = 0; ks < 8; ++ks) { qw[ks] = *(const u32x4*)(qp + 16 * ks); float f[8]; unpack8(qw[ks], f);
#pragma unroll
        for (int i = 0; i < 8; ++i) ss += f[i] * f[i]; }
    ss += __shfl_xor(ss, 32);
    const float sc = (1.0f / sqrtf(ss * (1.0f / 128.0f) + EPS)) * 0.08838834764831845f * LOG2E;
#pragma unroll
    for (int ks = 0; ks < 8; ++ks) { float f[8]; unpack8(qw[ks], f); const f32x4 w0 = *(const f32x4*)(qnw + 16 * ks + 8 * hi), w1 = *(const f32x4*)(qnw + 16 * ks + 8 * hi + 4);
        f[0] *= sc * w0.x; f[1] *= sc * w0.y; f[2] *= sc * w0.z; f[3] *= sc * w0.w; f[4] *= sc * w1.x; f[5] *= sc * w1.y; f[6] *= sc * w1.z; f[7] *= sc * w1.w;
        qf[ks] = __builtin_bit_cast(bf16x8, pack8(f)); }
}
__device__ __forceinline__ float red16(float v) { v += __shfl_xor(v, 1); v += __shfl_xor(v, 2); v += __shfl_xor(v, 4); v += __shfl_xor(v, 8); return v; }

__device__ __forceinline__ void attn_prompt_unit(const Frame& F, const Ptrs& P, int unit) {
    const int kvh = unit & 3, qb = (unit >> 2) & 31, b = unit >> 7, t0 = 64 * qb, rowb = b * SEQ;
    LAS unsigned char* Kl = F.lds + RING_OFF; LAS unsigned char* Vl = Kl + 192 * KS;
    for (int task = F.tid; task < 192 * 16; task += 512) {
        const int r = task >> 4, ch = task & 15, pos = t0 - 128 + r;
        u32x4 kw = (u32x4){0u, 0u, 0u, 0u}, vw = kw;
        if (pos >= 0) { const bf16* pr = P_PROJ + (size_t)(rowb + pos) * LDP + kvh * 128 + ch * 8; kw = *(const u32x4*)(pr + C_K); vw = *(const u32x4*)(pr + C_V); }
        float kf[8]; unpack8(kw, kf); float ss = 0.f;
#pragma unroll
        for (int i = 0; i < 8; ++i) ss += kf[i] * kf[i];
        ss = red16(ss);
        const float rstd = 1.0f / sqrtf(ss * (1.0f / 128.0f) + EPS);
        const f32x4 w0 = *(const f32x4*)(P_k_nw + ch * 8), w1 = *(const f32x4*)(P_k_nw + ch * 8 + 4);
        kf[0] *= rstd * w0.x; kf[1] *= rstd * w0.y; kf[2] *= rstd * w0.z; kf[3] *= rstd * w0.w; kf[4] *= rstd * w1.x; kf[5] *= rstd * w1.y; kf[6] *= rstd * w1.z; kf[7] *= rstd * w1.w;
        *(LAS u32x4*)(Kl + r * KS + ch * 16) = pack8(kf);
        *(LAS u32x4*)(Vl + r * VS + ch * 16) = vw;
        if (t0 >= SEQ - 128 && r >= 128) {
            const size_t o = (((size_t)b * 128 + (pos - (SEQ - 128))) * 4 + kvh) * 128 + ch * 8; float vf[8]; unpack8(vw, vf);
            *(f32x4*)(P_out + O_PK + o) = (f32x4){kf[0], kf[1], kf[2], kf[3]}; *(f32x4*)(P_out + O_PK + o + 4) = (f32x4){kf[4], kf[5], kf[6], kf[7]};
            *(f32x4*)(P_out + O_PV + o) = (f32x4){vf[0], vf[1], vf[2], vf[3]}; *(f32x4*)(P_out + O_PV + o + 4) = (f32x4){vf[4], vf[5], vf[6], vf[7]};
        }
    }
    __builtin_amdgcn_sched_barrier(0);
    const int q = F.lane & 31, hi = F.lane >> 5, g = F.wave >> 1, sub = F.wave & 1, head = kvh * 4 + g;
    const int row = rowb + t0 + 32 * sub + q;
    bf16x8 qf[8]; load_q(P_PROJ + (size_t)row * LDP + C_Q + head * 128 + 8 * hi, P_q_nw, hi, qf);
    __syncthreads();
    attn_task(Kl, Vl, sub, qf, 128 + q, 128 - t0 - 32 * sub, (const LAS float*)(F.lds + TB_OFF) + head * 128, P_sinks[head] * LOG2E, P_MIX + (size_t)row * DM + head * 128, F.lane);
}
__device__ __forceinline__ void attn_sample_unit(const Frame& F, const Ptrs& P, int unit) {
    const int kvh = unit & 3, b = unit >> 2;
    LAS unsigned char* Kl = F.lds + RING_OFF; LAS unsigned char* Vl = Kl + 160 * KS;
    for (int task = F.tid; task < 160 * 16; task += 512) {
        const int r = task >> 4, ch = task & 15;
        float kf[8], vf[8];
#pragma unroll
        for (int i = 0; i < 8; ++i) { kf[i] = 0.f; vf[i] = 0.f; }
        if (r < 128) {
            const size_t o = (((size_t)b * 128 + r) * 4 + kvh) * 128 + ch * 8;
            const f32x4 a0 = *(const f32x4*)(P_st_k + o), a1 = *(const f32x4*)(P_st_k + o + 4), c0 = *(const f32x4*)(P_st_v + o), c1 = *(const f32x4*)(P_st_v + o + 4);
            kf[0] = a0.x; kf[1] = a0.y; kf[2] = a0.z; kf[3] = a0.w; kf[4] = a1.x; kf[5] = a1.y; kf[6] = a1.z; kf[7] = a1.w;
            vf[0] = c0.x; vf[1] = c0.y; vf[2] = c0.z; vf[3] = c0.w; vf[4] = c1.x; vf[5] = c1.y; vf[6] = c1.z; vf[7] = c1.w;
            if (r >= 8) { const size_t o2 = o - (size_t)8 * 4 * 128; *(f32x4*)(P_out + O_SK + o2) = a0; *(f32x4*)(P_out + O_SK + o2 + 4) = a1; *(f32x4*)(P_out + O_SV + o2) = c0; *(f32x4*)(P_out + O_SV + o2 + 4) = c1; }
        } else if (r < 136) {
            const bf16* pr = P_PROJ + (size_t)(MP + b * 8 + (r - 128)) * LDP + kvh * 128 + ch * 8;
            unpack8(*(const u32x4*)(pr + C_K), kf); unpack8(*(const u32x4*)(pr + C_V), vf);
        }
        float ss = 0.f;
#pragma unroll
        for (int i = 0; i < 8; ++i) ss += kf[i] * kf[i];
        ss = red16(ss);
        if (r >= 128 && r < 136) {
            const float rstd = 1.0f / sqrtf(ss * (1.0f / 128.0f) + EPS);
            const f32x4 w0 = *(const f32x4*)(P_k_nw + ch * 8), w1 = *(const f32x4*)(P_k_nw + ch * 8 + 4);
            kf[0] *= rstd * w0.x; kf[1] *= rstd * w0.y; kf[2] *= rstd * w0.z; kf[3] *= rstd * w0.w; kf[4] *= rstd * w1.x; kf[5] *= rstd * w1.y; kf[6] *= rstd * w1.z; kf[7] *= rstd * w1.w;
            const size_t o2 = (((size_t)b * 128 + 120 + (r - 128)) * 4 + kvh) * 128 + ch * 8;
            *(f32x4*)(P_out + O_SK + o2) = (f32x4){kf[0], kf[1], kf[2], kf[3]}; *(f32x4*)(P_out + O_SK + o2 + 4) = (f32x4){kf[4], kf[5], kf[6], kf[7]};
            *(f32x4*)(P_out + O_SV + o2) = (f32x4){vf[0], vf[1], vf[2], vf[3]}; *(f32x4*)(P_out + O_SV + o2 + 4) = (f32x4){vf[4], vf[5], vf[6], vf[7]};
        }
        *(LAS u32x4*)(Kl + r * KS + ch * 16) = pack8(kf);
        *(LAS u32x4*)(Vl + r * VS + ch * 16) = pack8(vf);
    }
    __syncthreads();
    if (F.wave == 0) {
        const int q = F.lane & 31, hi = F.lane >> 5, g = q >> 3, i = q & 7, head = kvh * 4 + g, row = MP + b * 8 + i;
        bf16x8 qf[8]; load_q(P_PROJ + (size_t)row * LDP + C_Q + head * 128 + 8 * hi, P_q_nw, hi, qf);
        attn_task(Kl, Vl, 0, qf, 128 + i, 0, (const LAS float*)(F.lds + TB_OFF) + head * 128, P_sinks[head] * LOG2E, P_MIX + (size_t)row * DM + head * 128, F.lane);
    }
}

constexpr int XSTR = 144, BSTR = 272;
constexpr int L_XS = 0, L_XW = 18432, L_BS = 36864, L_CS = 71680, L_HS = 106496, L_ACS = 123904, L_DTV = 124416;
__device__ __forceinline__ void conv4_8(const bf16* src, int pos, const LAS float* cw, float (&o)[8], u32x4& center) {
    float acc[8];
#pragma unroll
    for (int i = 0; i < 8; ++i) acc[i] = cw[4 * 320 + i];
#pragma unroll
    for (int k = 0; k < 4; ++k) { u32x4 w = (u32x4){0u, 0u, 0u, 0u}; if (pos - 3 + k >= 0) w = *(const u32x4*)(src + (long)(k - 3) * LDP); if (k == 3) center = w;
        float f[8]; unpack8(w, f);
#pragma unroll
        for (int i = 0; i < 8; ++i) acc[i] += cw[k * 320 + i] * f[i]; }
#pragma unroll
    for (int i = 0; i < 8; ++i) o[i] = silu_f(acc[i]);
}
__device__ __forceinline__ void store8f(float* p, const u32x4 w) { float f[8]; unpack8(w, f); *(f32x4*)p = (f32x4){f[0], f[1], f[2], f[3]}; *(f32x4*)(p + 4) = (f32x4){f[4], f[5], f[6], f[7]}; }

__device__ __forceinline__ void ssd_prompt_unit(const Frame& F, const Ptrs& P, int unit) {
    const int h = unit & 31, b = unit >> 5, grp = h >> 2, rowb0 = b * SEQ;
    LAS unsigned char* L = F.lds + RING_OFF;
    LAS float* CWL = (LAS float*)(F.lds + CWL_OFF); LAS float* ACS = (LAS float*)(L + L_ACS); LAS float* DTV = (LAS float*)(L + L_DTV);
    for (int i = F.tid; i < 5 * 320; i += 512) { const int k = i / 320, ci = i % 320; const int ch = ci < 64 ? h * 64 + ci : (ci < 192 ? 2048 + grp * 128 + (ci - 64) : 3072 + grp * 128 + (ci - 192));
        CWL[i] = k < 4 ? P_conv_w[k * 4096 + ch] : P_conv_b[ch]; }
    for (int i = F.tid; i < 64 * BSTR / 4; i += 512) ((LAS unsigned*)(L + L_HS))[i] = 0u;
    f32x16 hacc; for (int i = 0; i < 16; ++i) hacc[i] = 0.f;
    const float Ah = -__expf(P_A_log[h]), Dh = P_Dv[h], dtb = P_dt_bias[h];
    const int q = F.lane & 31, hi = F.lane >> 5, g4 = F.lane >> 4, i16 = F.lane & 15;
    for (int c = 0; c < 16; ++c) {
        __syncthreads();
        const int rowb = rowb0 + 128 * c;
        if (F.wave == 0) {
            const int ta = 2 * F.lane;
            const float dv0 = softplus_f(bf2f(P_PROJ[(size_t)(rowb + ta) * LDP + C_DT + h]) + dtb), dv1 = softplus_f(bf2f(P_PROJ[(size_t)(rowb + ta + 1) * LDP + C_DT + h]) + dtb);
            const float a0 = dv0 * Ah, a1 = dv1 * Ah; float s = a0 + a1;
#pragma unroll
            for (int off = 1; off < 64; off <<= 1) { const float t = __shfl_up(s, off); if (F.lane >= off) s += t; }
            ACS[ta] = s - a1; ACS[ta + 1] = s; DTV[ta] = dv0; DTV[ta + 1] = dv1;
        }
        for (int task = F.tid; task < 1024; task += 512) { const int l = task >> 3, cc = task & 7; float o[8]; u32x4 ctr;
            conv4_8(P_PROJ + (size_t)(rowb + l) * LDP + C_X + h * 64 + cc * 8, 128 * c + l, CWL + cc * 8, o, ctr);
            *(LAS u32x4*)(L + L_XS + l * XSTR + cc * 16) = pack8(o);
            if (c == 15 && l >= 125) store8f(P_out + O_PCONV + ((size_t)b * 3 + (l - 125)) * 4096 + h * 64 + cc * 8, ctr); }
        for (int task = F.tid; task < 2048; task += 512) { const int l = task >> 4, cc = task & 15; float o[8]; u32x4 ctr;
            conv4_8(P_PROJ + (size_t)(rowb + l) * LDP + C_X + 2048 + grp * 128 + cc * 8, 128 * c + l, CWL + 64 + cc * 8, o, ctr);
            *(LAS u32x4*)(L + L_BS + l * BSTR + cc * 16) = pack8(o);
            if (c == 15 && l >= 125 && (h & 3) == 0) store8f(P_out + O_PCONV + ((size_t)b * 3 + (l - 125)) * 4096 + 2048 + grp * 128 + cc * 8, ctr); }
        for (int task = F.tid; task < 2048; task += 512) { const int l = task >> 4, cc = task & 15; float o[8]; u32x4 ctr;
            conv4_8(P_PROJ + (size_t)(rowb + l) * LDP + C_X + 3072 + grp * 128 + cc * 8, 128 * c + l, CWL + 192 + cc * 8, o, ctr);
            *(LAS u32x4*)(L + L_CS + l * BSTR + cc * 16) = pack8(o);
            if (c == 15 && l >= 125 && (h & 3) == 0) store8f(P_out + O_PCONV + ((size_t)b * 3 + (l - 125)) * 4096 + 3072 + grp * 128 + cc * 8, ctr); }
        __syncthreads();
        const float acs_end = ACS[127];
        for (int task = F.tid; task < 1024; task += 512) { const int l = task >> 3, cc = task & 7; float f[8]; unpack8(*(const LAS u32x4*)(L + L_XS + l * XSTR + cc * 16), f);
            const float sc = DTV[l] * __expf(acs_end - ACS[l]);
#pragma unroll
            for (int i = 0; i < 8; ++i) f[i] *= sc;
            *(LAS u32x4*)(L + L_XW + l * XSTR + cc * 16) = pack8(f); }
        __syncthreads();
        {
            const int pt = F.wave & 1, lt = F.wave >> 1, l = 32 * lt + q;
            bf16x8 cf[8];
#pragma unroll
            for (int ks = 0; ks < 8; ++ks) cf[ks] = *(const LAS bf16x8*)(L + L_CS + l * BSTR + ks * 32 + hi * 16);
            f32x16 y; for (int i = 0; i < 16; ++i) y[i] = 0.f;
            if (c > 0) {
#pragma unroll
                for (int ks = 0; ks < 8; ++ks) y = MFMA32(*(const LAS bf16x8*)(L + L_HS + (32 * pt + q) * BSTR + ks * 32 + hi * 16), cf[ks], y);
            }
            const float acs_l = ACS[l], ea = __expf(acs_l);
#pragma unroll
            for (int i = 0; i < 16; ++i) y[i] *= ea;
            for (int st = 0; st <= lt; ++st) {
                f32x16 g; for (int i = 0; i < 16; ++i) g[i] = 0.f;
#pragma unroll
                for (int ks = 0; ks < 8; ++ks) g = MFMA32(*(const LAS bf16x8*)(L + L_BS + (32 * st + q) * BSTR + ks * 32 + hi * 16), cf[ks], g);
#pragma unroll
                for (int r = 0; r < 16; ++r) { const int s = 32 * st + crow(r, hi); g[r] = (s <= l) ? g[r] * __expf(acs_l - ACS[s]) * DTV[s] : 0.f; }
#pragma unroll
                for (int s2 = 0; s2 < 2; ++s2) { const bf16x8 pf = pack_step(g, s2);
                    const LAS unsigned char* a = L + L_XS + (32 * st + 16 * s2 + 4 * hi + (i16 >> 2)) * XSTR + (32 * pt + (g4 & 1) * 16 + (i16 & 3) * 4) * 2;
                    y = MFMA32(cat4(vtr(a), vtr(a + 8 * XSTR)), pf, y); }
            }
            const int row = rowb + l; const bf16* zp = P_PROJ + (size_t)row * LDP + C_Z + h * 64 + 32 * pt + 4 * hi; float ssq = 0.f;
#pragma unroll
            for (int r4 = 0; r4 < 4; ++r4) { const u32x2 zw = *(const u32x2*)(zp + 8 * r4); const u32x2 xw = *(const LAS u32x2*)(L + L_XS + l * XSTR + (32 * pt + 8 * r4 + 4 * hi) * 2);
                const f32x4 nw = *(const f32x4*)(P_ssd_nw + h * 64 + 32 * pt + 8 * r4 + 4 * hi);
                const float z0 = bflo(zw.x), z1 = bfhi(zw.x), z2 = bflo(zw.y), z3 = bfhi(zw.y);
                const float g0 = (y[4 * r4] + Dh * bflo(xw.x)) * silu_f(z0), g1 = (y[4 * r4 + 1] + Dh * bfhi(xw.x)) * silu_f(z1), g2 = (y[4 * r4 + 2] + Dh * bflo(xw.y)) * silu_f(z2), g3 = (y[4 * r4 + 3] + Dh * bfhi(xw.y)) * silu_f(z3);
                ssq += (g0 * g0 + g1 * g1) + (g2 * g2 + g3 * g3);
                u32x2 w; w.x = cvtpk(g0 * nw.x, g1 * nw.y); w.y = cvtpk(g2 * nw.z, g3 * nw.w);
                *(u32x2*)(P_MIX + (size_t)row * DM + 2048 + h * 64 + 32 * pt + 8 * r4 + 4 * hi) = w; }
            ssq += __shfl_xor(ssq, 32);
            if (hi == 0) atomicAdd(P_ssq + row, ssq);
        }
        __syncthreads();
        {
            const int pt = F.wave & 1, nt = F.wave >> 1; const float eend = __expf(acs_end);
#pragma unroll
            for (int i = 0; i < 16; ++i) hacc[i] *= eend;
#pragma unroll
            for (int ks = 0; ks < 8; ++ks) { const int srow = 16 * ks + 8 * hi + (i16 >> 2), cofs = ((g4 & 1) * 16 + (i16 & 3) * 4) * 2;
                const LAS unsigned char* a = L + L_XW + srow * XSTR + 64 * pt + cofs; const LAS unsigned char* bp = L + L_BS + srow * BSTR + 64 * nt + cofs;
                hacc = MFMA32(cat4(vtr(a), vtr(a + 4 * XSTR)), cat4(vtr(bp), vtr(bp + 4 * BSTR)), hacc); }
#pragma unroll
            for (int r = 0; r < 16; ++r) *(LAS unsigned short*)(L + L_HS + (32 * pt + crow(r, hi)) * BSTR + (32 * nt + q) * 2) = (unsigned short)(cvtpk(hacc[r], 0.f) & 0xffffu);
        }
    }
    {   const int pt = F.wave & 1, nt = F.wave >> 1;
#pragma unroll
        for (int r = 0; r < 16; ++r) P_out[O_PSSM + ((size_t)(b * 32 + h) * 64 + 32 * pt + crow(r, hi)) * 128 + 32 * nt + q] = hacc[r]; }
}

__device__ __forceinline__ void ssd_sample_unit(const Frame& F, const Ptrs& P, int unit) {
    const int grp = unit & 7, b = unit >> 3;
    LAS float* XC = (LAS float*)(F.lds + RING_OFF); LAS float* BC = XC + 2048; LAS float* CC = BC + 1024; LAS float* DTVs = CC + 1024; LAS float* DAs = DTVs + 32; LAS float* ZC = DAs + 32;
    {   const int ci = F.tid; int ch, stride; LAS float* dst;
        if (ci < 256) { ch = grp * 256 + ci; dst = XC + ci; stride = 256; } else if (ci < 384) { ch = 2048 + grp * 128 + (ci - 256); dst = BC + (ci - 256); stride = 128; } else { ch = 3072 + grp * 128 + (ci - 384); dst = CC + (ci - 384); stride = 128; }
        float xp[11];
#pragma unroll
        for (int j = 0; j < 3; ++j) xp[j] = P_st_conv[((size_t)b * 3 + j) * 4096 + ch];
#pragma unroll
        for (int t = 0; t < 8; ++t) xp[3 + t] = bf2f(P_PROJ[(size_t)(MP + b * 8 + t) * LDP + C_X + ch]);
        const float w0 = P_conv_w[ch], w1 = P_conv_w[4096 + ch], w2 = P_conv_w[8192 + ch], w3 = P_conv_w[12288 + ch], bb = P_conv_b[ch];
#pragma unroll
        for (int t = 0; t < 8; ++t) dst[t * stride] = silu_f(bb + w0 * xp[t] + w1 * xp[t + 1] + w2 * xp[t + 2] + w3 * xp[t + 3]);
#pragma unroll
        for (int j = 0; j < 3; ++j) P_out[O_SCONV + ((size_t)b * 3 + j) * 4096 + ch] = xp[8 + j];
        if (ci < 256) {
#pragma unroll
            for (int t = 0; t < 8; ++t) ZC[t * 256 + ci] = bf2f(P_PROJ[(size_t)(MP + b * 8 + t) * LDP + C_Z + grp * 256 + ci]); }
    }
    if (F.tid < 32) { const int hh = F.tid >> 3, t = F.tid & 7, h = grp * 4 + hh;
        const float dv = softplus_f(bf2f(P_PROJ[(size_t)(MP + b * 8 + t) * LDP + C_DT + h]) + P_dt_bias[h]); DTVs[F.tid] = dv; DAs[F.tid] = __expf(-dv * __expf(P_A_log[h])); }
    __syncthreads();
    const int hh = F.wave >> 1, half = F.wave & 1, h = grp * 4 + hh, n4 = F.lane & 31, prow = F.lane >> 5;
    const size_t sofs = ((size_t)(b * 32 + h) * 64 + 32 * half + prow) * 128 + 4 * n4;
    f32x4 hreg[16];
#pragma unroll
    for (int i = 0; i < 16; ++i) hreg[i] = *(const f32x4*)(P_st_ssm + sofs + (size_t)(2 * i) * 128);
    const float Dh = P_Dv[h]; const bool valid = n4 < 16; const int p = 32 * half + 2 * (n4 & 15) + prow; const float nw = P_ssd_nw[h * 64 + p];
#pragma unroll 1
    for (int t = 0; t < 8; ++t) {
        const float da = DAs[hh * 8 + t], dv = DTVs[hh * 8 + t]; const f32x4 B4 = *(const LAS f32x4*)(BC + t * 128 + 4 * n4), C4 = *(const LAS f32x4*)(CC + t * 128 + 4 * n4);
        float yt = 0.f;
#pragma unroll
        for (int i = 0; i < 16; ++i) { const float xv = XC[t * 256 + hh * 64 + 32 * half + 2 * i + prow] * dv; hreg[i] = hreg[i] * da + xv * B4;
            float part = (hreg[i].x * C4.x + hreg[i].y * C4.y) + (hreg[i].z * C4.z + hreg[i].w * C4.w);
            part += __shfl_xor(part, 1); part += __shfl_xor(part, 2); part += __shfl_xor(part, 4); part += __shfl_xor(part, 8); part += __shfl_xor(part, 16);
            if (n4 == i) yt = part; }
        const int row = MP + b * 8 + t;
        const float x = XC[t * 256 + hh * 64 + p], z = ZC[t * 256 + hh * 64 + p]; const float yg = (yt + Dh * x) * silu_f(z);
        const float ss = wave_sum(valid ? yg * yg : 0.f);
        if (F.lane == 0) atomicAdd(P_ssq + row, ss);
        if (valid) P_MIX[(size_t)row * DM + 2048 + h * 64 + p] = (bf16)(cvtpk(yg * nw, 0.f) & 0xffffu);
    }
#pragma unroll
    for (int i = 0; i < 16; ++i) *(f32x4*)(P_out + O_SSSM + sofs + (size_t)(2 * i) * 128) = hreg[i];
}

__device__ __forceinline__ void p2_mixer(const Frame& F, const Ptrs& P, volatile LAS unsigned* slot) {
    {
        LAS float* TB = (LAS float*)(F.lds + TB_OFF);
        for (int i = F.tid; i < 16 * 128; i += 512) { const int hd = i >> 7, dist = i & 127; TB[i] = P_rel_bias[t5_bucket(dist) * 16 + hd] * LOG2E; }
    }
#ifndef MIX_MASK
#define MIX_MASK 15
#endif
    if (MIX_MASK & 1) for (;;) { const int u = wq_next(P_ctl + CW_Q + 0 * 64, slot, F.tid); if (u >= 128) break; ssd_prompt_unit(F, P, u); }
    if (MIX_MASK & 2) for (;;) { const int u = wq_next(P_ctl + CW_Q + 1 * 64, slot, F.tid); if (u >= 512) break; attn_prompt_unit(F, P, u); }
    if (MIX_MASK & 4) for (;;) { const int u = wq_next(P_ctl + CW_Q + 2 * 64, slot, F.tid); if (u >= 512) break; attn_sample_unit(F, P, u); }
    if (MIX_MASK & 8) { Frame F2 = F; asm volatile("" : "+v"(F2.tid), "+v"(F2.lane));
        for (;;) { const int u = wq_next(P_ctl + CW_Q + 3 * 64, slot, F2.tid); if (u >= 1024) break; ssd_sample_unit(F2, P, u); } }
}

__device__ __forceinline__ void p3_ssd_norm(const Frame& F, const Ptrs& P) {
    const int gw = F.bid * NWAVES + F.wave, NGW = F.G * NWAVES;
    for (int m = gw; m < M; m += NGW) { const float rstd = 1.0f / sqrtf(P_ssq[m] * (1.0f / 2048.0f) + EPS); u32x4* mp = (u32x4*)(P_MIX + (size_t)m * DM + 2048) + F.lane;
#pragma unroll
        for (int j = 0; j < 4; ++j) { float f[8]; unpack8(mp[64 * j], f);
#pragma unroll
            for (int i = 0; i < 8; ++i) f[i] *= rstd;
            mp[64 * j] = pack8(f); } }
}
__device__ __forceinline__ void p5_ffn_norm(const Frame& F, const Ptrs& P) {
    const int gw = F.bid * NWAVES + F.wave, NGW = F.G * NWAVES;
    for (int m = gw; m < M; m += NGW) rms_row_to_bf16(P_out + (size_t)m * DM, P_ffn_nw, P_XN + (size_t)m * DM, F.lane);
}
__device__ __forceinline__ void p7_conv_act(const Frame& F, const Ptrs& P) {
    constexpr int NCC = DFF / 8; const int ntask = (M / 8) * NCC;
    for (int task = F.bid * 512 + F.tid; task < ntask; task += F.G * 512) {
        const int cc = task % NCC, rb = task / NCC, j0 = cc * 8, gcol = 256 * (j0 >> 7) + (j0 & 127), r0 = rb * 8;
        float w0[8], w1[8], w2[8], bb[8], pm2[8], pm1[8];
#pragma unroll
        for (int i = 0; i < 8; ++i) { w0[i] = P_fconv_w[j0 + i]; w1[i] = P_fconv_w[DFF + j0 + i]; w2[i] = P_fconv_w[2 * DFF + j0 + i]; bb[i] = P_fconv_b[j0 + i]; pm2[i] = 0.f; pm1[i] = 0.f; }
        if (r0 < MP) { if ((r0 & (SEQ - 1)) != 0) { unpack8(*(const u32x4*)(P_GU + (size_t)(r0 - 2) * NGU + gcol), pm2); unpack8(*(const u32x4*)(P_GU + (size_t)(r0 - 1) * NGU + gcol), pm1); } }
        else { const int bs = (r0 - MP) >> 3;
#pragma unroll
            for (int i = 0; i < 8; ++i) { pm2[i] = P_st_ffn[((size_t)bs * 2 + 0) * DFF + j0 + i]; pm1[i] = P_st_ffn[((size_t)bs * 2 + 1) * DFF + j0 + i]; } }
#pragma unroll
        for (int t = 0; t < 8; ++t) { const int r = r0 + t; float g[8], u[8], a[8];
            unpack8(*(const u32x4*)(P_GU + (size_t)r * NGU + gcol), g); unpack8(*(const u32x4*)(P_GU + (size_t)r * NGU + gcol + 128), u);
#pragma unroll
            for (int i = 0; i < 8; ++i) a[i] = silu_f(bb[i] + w0[i] * pm2[i] + w1[i] * pm1[i] + w2[i] * g[i]) * u[i];
            *(u32x4*)(P_ACT + (size_t)r * DFF + j0) = pack8(a);
            if (r < MP) { const int pos = r & (SEQ - 1); if (pos >= SEQ - 2) { float* o = P_out + O_PFFN + ((size_t)(r >> 11) * 2 + (pos - (SEQ - 2))) * DFF + j0;
                *(f32x4*)o = (f32x4){g[0], g[1], g[2], g[3]}; *(f32x4*)(o + 4) = (f32x4){g[4], g[5], g[6], g[7]}; } }
            else if (t >= 6) { float* o = P_out + O_SFFN + ((size_t)((r0 - MP) >> 3) * 2 + (t - 6)) * DFF + j0; *(f32x4*)o = (f32x4){g[0], g[1], g[2], g[3]}; *(f32x4*)(o + 4) = (f32x4){g[4], g[5], g[6], g[7]}; }
#pragma unroll
            for (int i = 0; i < 8; ++i) { pm2[i] = pm1[i]; pm1[i] = g[i]; } }
    }
}

__global__ void __launch_bounds__(NWAVES * 64, 2) hymba_fwd(Args args) {
    extern __shared__ __attribute__((aligned(16))) unsigned char lds_raw[];
    Frame F; F.lds = (LAS unsigned char*)lds_raw; F.tid = threadIdx.x; F.lane = F.tid & 63; F.wave = __builtin_amdgcn_readfirstlane(F.tid >> 6); F.G = KARG->grid; F.bid = blockIdx.x;
    volatile LAS unsigned* MISC = (volatile LAS unsigned*)(F.lds + MISC_OFF);
    Ptrs P;
    for (int u = F.tid; u < (LDS_BYTES - LDSCTL_OFF) / 4; u += NWAVES * 64) ((LAS unsigned*)(F.lds + LDSCTL_OFF))[u] = 0u;
    __syncthreads();
    if (N_LAUNCHES == 1) (void)xcd_barrier_post((unsigned*)(P_ctl + CW_BAR), MISC + 8);
    const int lo = KARG->ph_lo, hi = KARG->ph_hi;
#ifndef PHASE_MASK
#define PHASE_MASK 0x1ff
#endif
#define IN(k) ((((PHASE_MASK) >> (k)) & 1) && lo <= (k) && (k) < hi)
#define SEAM(k) do { if (IN(k) && IN((k) + 1)) { XcdBarrier b_; b_.bar = (unsigned*)(P_ctl + CW_BAR); b_.x = xb_xcc_id(); b_.st = MISC + 8; xcd_barrier(b_); } } while (0)

    if (IN(0)) { p0_prologue(F, P); } SEAM(0);
    if (IN(1)) {
        pg8::Gemm g{P_XN, P_W1, M, LDP, DM}; pg8::StaticOrder S; S.init(M, LDP, F.G, F.bid);
        pg8::EpiStoreBf16 E{P_PROJ, LDP};
        pg8::gemm_phase<pg8::EpiStoreBf16, pg8::StaticOrder, PG8_ALIGN, PG8_SP2>(F.lds + RING_OFF, g, S, E);
    } SEAM(1);
    if (IN(2)) { p2_mixer(F, P, MISC + 4); } SEAM(2);
    if (IN(3)) { p3_ssd_norm(F, P); } SEAM(3);
    if (IN(4)) {
        pg8::Gemm g{P_MIX, P_W2, M, DM, DM}; pg8::StaticOrder S; S.init(M, DM, F.G, F.bid);
        pg8::EpiResF32 E{P_x_prompt, P_x_sample, MP, P_out, DM};
        pg8::gemm_phase<pg8::EpiResF32, pg8::StaticOrder, PG8_ALIGN, PG8_SP2>(F.lds + RING_OFF, g, S, E);
    } SEAM(4);
    if (IN(5)) { p5_ffn_norm(F, P); } SEAM(5);
    if (IN(6)) {
        pg8::Gemm g{P_XN, P_W3, M, NGU, DM}; pg8::StaticOrder S; S.init(M, NGU, F.G, F.bid);
        pg8::EpiStoreBf16 E{P_GU, NGU};
        pg8::gemm_phase<pg8::EpiStoreBf16, pg8::StaticOrder, PG8_ALIGN, PG8_SP2>(F.lds + RING_OFF, g, S, E);
    } SEAM(6);
    if (IN(7)) { p7_conv_act(F, P); } SEAM(7);
    if (IN(8)) {
        pg8::Gemm g{P_ACT, P_W4, M, DM, DFF}; pg8::StaticOrder S; S.init(M, DM, F.G, F.bid);
        pg8::EpiResF32 E{P_out, P_out, M, P_out, DM};
        pg8::gemm_phase<pg8::EpiResF32, pg8::StaticOrder, PG8_ALIGN, PG8_SP2>(F.lds + RING_OFF, g, S, E);
    }
#undef IN
#undef SEAM
}

extern "C" void kernel_launch(void* const* d_in, const int* in_sizes, int n_in, void* d_out, int out_size, void* d_ws, size_t ws_size, hipStream_t stream) {
    static int grid = 0;
    if (grid == 0) {
        if (n_in != 26 || (size_t)out_size != O_END || ws_size < WS_END) { fprintf(stderr, "kernel_launch: unexpected shapes: n_in %d out %d ws %zu (need %zu); nothing launched\n", n_in, out_size, ws_size, (size_t)WS_END); grid = -1; return; }
        int dev = 0, cus = 0, per_cu = 0;
        if (hipGetDevice(&dev) != hipSuccess || hipDeviceGetAttribute(&cus, hipDeviceAttributeMultiprocessorCount, dev) != hipSuccess) { grid = -1; return; }
        if (hipFuncSetAttribute((const void*)hymba_fwd, hipFuncAttributeMaxDynamicSharedMemorySize, LDS_BYTES) != hipSuccess) { fprintf(stderr, "kernel_launch: hipFuncSetAttribute failed\n"); grid = -1; return; }
        if (hipOccupancyMaxActiveBlocksPerMultiprocessor(&per_cu, (const void*)hymba_fwd, NWAVES * 64, LDS_BYTES) != hipSuccess || per_cu < 1) { fprintf(stderr, "kernel_launch: occupancy query reports %d blocks per CU\n", per_cu); }
        (void)hipGetLastError();
        grid = cus;
    }
    if (grid < 0) return;
    if (hipMemsetAsync((char*)d_ws + WS_CTL, 0, CTL_ZERO_BYTES, stream) != hipSuccess) return;
    Args a{};
    for (int i = 0; i < 26; ++i) a.in[i] = (const float*)d_in[i];
    a.out = (float*)d_out; a.ws = (unsigned char*)d_ws; a.grid = grid; a.pad = 0;
    if (N_LAUNCHES == 1) { a.ph_lo = 0; a.ph_hi = N_PHASES; hipLaunchKernelGGL(hymba_fwd, dim3(grid), dim3(NWAVES * 64), LDS_BYTES, stream, a); }
    else { for (int li = 0; li < N_PHASES; ++li) { a.ph_lo = li; a.ph_hi = li + 1; hipLaunchKernelGGL(hymba_fwd, dim3(grid), dim3(NWAVES * 64), LDS_BYTES, stream, a); } }
}
```

```cpp
#include <hip/hip_runtime.h>
#include <cstdio>
#include <cstdint>
namespace pg8 {
#define PG8_LAS __attribute__((address_space(3)))
typedef unsigned short bf16_t;
typedef short bf16x8 __attribute__((ext_vector_type(8)));
typedef float f32x4 __attribute__((ext_vector_type(4)));
typedef unsigned u32x4 __attribute__((ext_vector_type(4)));
constexpr int BM = 256, BK = 64, HALF = 128, HTB = HALF * BK * 2  , STAGE_BYTES = 8 * HTB, NXCD = 8, WGM = 8;

__host__ __device__ __forceinline__ int lds_byte(int r, int c) { const int st = (r >> 4) * 2 + (c >> 5), rr = r & 15, cc = c & 31, ob = rr * 64 + cc * 2; return st * 1024 + (ob ^ (((ob >> 9) & 1) << 5)); }
__host__ __device__ __forceinline__ void stage_rc(int b, int& R, int& C) { const int st = b / 1024, sb = b % 1024, swz = sb ^ (((sb >> 9) & 1) << 5); R = (st >> 1) * 16 + swz / 64; C = (st & 1) * 32 + (swz % 64) / 2; }
__host__ __device__ __forceinline__ int perm32(int rho) { const int n = rho >> 4, i = rho & 15; return 8 * (i >> 2) + 4 * n + (i & 3); }

struct Unit { int pm, pn, kt0, nt, aux; };
struct Gemm { const bf16_t* A; const bf16_t* Bt; int M, N, K; };

struct StaticOrder {
    int nM, nN, nwg, G, c, ntf, pm0;
    __host__ __device__ void init(int M, int N, int G_, int c_, int K_ = 0, int pm0_ = 0) { nM = M / BM; nN = N / BM; nwg = nM * nN; G = G_; c = c_; ntf = K_ / BK; pm0 = pm0_; }
    __host__ __device__ bool next(int i, Unit& u) const {
        const long L = (long)i * G + c; if (L >= nwg) return false;
        int wgid = (int)L; { const int q = nwg / NXCD, r = nwg % NXCD, xcd = wgid % NXCD, off = wgid / NXCD; wgid = (xcd < r ? xcd * (q + 1) : r * (q + 1) + (xcd - r) * q) + off; }
        const int nig = WGM * nN, gid = wgid / nig, fm = gid * WGM, gsz = (nM - fm) < WGM ? (nM - fm) : WGM;
        u.pm = pm0 + fm + ((wgid % nig) % gsz); u.pn = (wgid % nig) / gsz; u.kt0 = 0; u.nt = ntf; u.aux = 0; return true;
    }
    __device__ __forceinline__ void a_ready(const Unit&) const {}
    __device__ __forceinline__ void done(const Unit&) const {}
};

__device__ __forceinline__ unsigned cvt_pk_bf16(float lo, float hi) { unsigned r; asm volatile("v_cvt_pk_bf16_f32 %0, %1, %2" : "=v"(r) : "v"(lo), "v"(hi)); return r; }
typedef float f32x2 __attribute__((ext_vector_type(2)));

struct EpiStoreBf16 {
    static constexpr bool PERM = true, AFTER_DRAIN = false;
    bf16_t* O; int ldc;
    __device__ __forceinline__ void operator()(const f32x4 (&acc)[2][2][4][2], const Unit& u, int wr, int wc, int fr, int fq) const {
        const int row0 = u.pm * BM + wr * 64 + fr; const int col0 = u.pn * BM + wc * 32 + 8 * fq;
#pragma unroll
        for (int ai = 0; ai < 2; ++ai)
#pragma unroll
            for (int m = 0; m < 4; ++m) { bf16_t* rowp = O + (size_t)(row0 + ai * HALF + m * 16) * ldc + col0;
#pragma unroll
                for (int bj = 0; bj < 2; ++bj) { const f32x4 v0 = acc[ai][bj][m][0], v1 = acc[ai][bj][m][1];
                    u32x4 w; w.x = cvt_pk_bf16(v0[0], v0[1]); w.y = cvt_pk_bf16(v0[2], v0[3]); w.z = cvt_pk_bf16(v1[0], v1[1]); w.w = cvt_pk_bf16(v1[2], v1[3]);
                    *(u32x4*)(rowp + bj * HALF) = w; } }
    }
};
struct EpiResF32 {
    static constexpr bool PERM = false, AFTER_DRAIN = false;
    const float* base0; const float* base1; int split_row; float* out; int ldc;
    __device__ __forceinline__ void operator()(const f32x4 (&acc)[2][2][4][2], const Unit& u, int wr, int wc, int fr, int fq) const {
        const int row0 = u.pm * BM + wr * 64 + fr; const int col0 = u.pn * BM + wc * 32 + 4 * fq;
        const float* base = (u.pm * BM >= split_row) ? (base1 - (size_t)split_row * ldc) : base0;
#pragma unroll
        for (int ai = 0; ai < 2; ++ai)
#pragma unroll
            for (int m = 0; m < 4; ++m) { const size_t off = (size_t)(row0 + ai * HALF + m * 16) * ldc + col0;
#pragma unroll
                for (int bj = 0; bj < 2; ++bj)
#pragma unroll
                    for (int n = 0; n < 2; ++n) { const f32x4 b = *(const f32x4*)(base + off + bj * HALF + n * 16); *(f32x4*)(out + off + bj * HALF + n * 16) = b + acc[ai][bj][m][n]; }
                if (m & 1) asm volatile("" ::: "memory"); }
    }
};

struct EpiSlab {
    static constexpr bool PERM = false, AFTER_DRAIN = false;
    float* slab;
    __device__ __forceinline__ void operator()(const f32x4 (&acc)[2][2][4][2], const Unit& u, int wr, int wc, int fr, int fq) const {
        float* sp = slab + (size_t)u.aux * 65536 + (wr * 64 + fr) * 256 + wc * 32 + 4 * fq;
#pragma unroll
        for (int ai = 0; ai < 2; ++ai)
#pragma unroll
            for (int m = 0; m < 4; ++m)
#pragma unroll
                for (int bj = 0; bj < 2; ++bj)
#pragma unroll
                    for (int n = 0; n < 2; ++n) *(f32x4*)(sp + (ai * HALF + m * 16) * 256 + bj * HALF + n * 16) = acc[ai][bj][m][n];
    }
};
struct PieceOrder {
    int G, c, pm0, nN, npieces, ntA, ntB;
    __device__ __forceinline__ bool next(int i, Unit& u) const {
        const int L = i * G + c; if (L >= npieces) return false;
        const int kp = L & 3, tile = L >> 2; u.pn = tile % nN; u.pm = pm0 + tile / nN; u.aux = L;
        if (kp < 2) { u.nt = ntA; u.kt0 = kp * ntA; } else { u.nt = ntB; u.kt0 = 2 * ntA + (kp - 2) * ntB; }
        return true;
    }
    __device__ __forceinline__ void a_ready(const Unit&) const {}
    __device__ __forceinline__ void done(const Unit&) const {}
};
template <class Epi, class Sched, bool ALIGN_EPI = false, bool SP2 = false>
__device__ __forceinline__ void gemm_phase(PG8_LAS unsigned char* lds, const Gemm g, const Sched& S, const Epi& E) {
    const int tid = threadIdx.x, wid = __builtin_amdgcn_readfirstlane(tid >> 6), lane = tid & 63, wr = wid >> 2, wc = wid & 3, fr = lane & 15, fq = lane >> 4;
    const int K = g.K; int nt;
    unsigned voffA[2], voffB[2];
#pragma unroll
    for (int i = 0; i < 2; ++i) { int R, C; stage_rc(tid * 16 + i * 8192, R, C); const int Rb = Epi::PERM ? ((R & ~31) + perm32(R & 31)) : R;
        voffA[i] = (unsigned)(R * K + C) * 2u; voffB[i] = (unsigned)(Rb * K + C) * 2u; }
    const size_t kstep = (size_t)(BK * 2);
    const size_t hstep = (size_t)HALF * K * 2;
    const size_t tstep = 2 * hstep;
    const unsigned ldsw = (unsigned)wid * 1024u;
    const int aoff = lds_byte(wr * 64 + fr, fq * 8), boff = lds_byte(wc * 32 + fr, fq * 8);
#define PG8_SA(b, h) (((b) * 2 + (h)) * HTB)
#define PG8_SB(b, h) ((4 + (b) * 2 + (h)) * HTB)
#define PG8_STAGE(bufoff, gbase, voff) do { _Pragma("unroll") for (int _i = 0; _i < 2; ++_i) \
        __builtin_amdgcn_global_load_lds((const unsigned*)((const char*)(gbase) + (voff)[_i]), (PG8_LAS unsigned*)(lds + (bufoff) + ldsw + _i * 8192), 16, 0, 0); } while (0)
#define PG8_LDA(dst, b, h) do { _Pragma("unroll") for (int m = 0; m < 4; ++m) _Pragma("unroll") for (int k = 0; k < 2; ++k) dst[m][k] = *(const PG8_LAS bf16x8*)(lds + PG8_SA(b, h) + aoff + m * 2048 + k * 1024); } while (0)
#define PG8_LDB(dst, b, h) do { _Pragma("unroll") for (int n = 0; n < 2; ++n) _Pragma("unroll") for (int k = 0; k < 2; ++k) dst[n][k] = *(const PG8_LAS bf16x8*)(lds + PG8_SB(b, h) + boff + n * 2048 + k * 1024); } while (0)
#define PG8_MMA(ai, bj, At, Bt) do { __builtin_amdgcn_s_setprio(1); _Pragma("unroll") for (int m = 0; m < 4; ++m) _Pragma("unroll") for (int n = 0; n < 2; ++n) _Pragma("unroll") for (int k = 0; k < 2; ++k) \
        acc[ai][bj][m][n] = __builtin_amdgcn_mfma_f32_16x16x32_bf16(Bt[n][k], At[m][k], acc[ai][bj][m][n], 0, 0, 0); __builtin_amdgcn_s_setprio(0); } while (0)
#define PG8_WAIT_V(n) asm volatile("s_waitcnt vmcnt(" #n ")" ::: "memory")
#define PG8_WAIT_L(n) asm volatile("s_waitcnt lgkmcnt(" #n ")" ::: "memory")
#define PG8_BAR __builtin_amdgcn_s_barrier()
#define PG8_SCHED __builtin_amdgcn_sched_barrier(0)
    Unit cur, nxt; int ui = 0;
    if (!S.next(0, cur)) return;
    nt = cur.nt;
    f32x4 acc[2][2][4][2];
#pragma unroll
    for (int a = 0; a < 2; ++a)
#pragma unroll
        for (int b = 0; b < 2; ++b)
#pragma unroll
            for (int m = 0; m < 4; ++m)
#pragma unroll
                for (int n = 0; n < 2; ++n) acc[a][b][m][n] = (f32x4){0.f, 0.f, 0.f, 0.f};
    bf16x8 At[4][2], B0[2][2], B1[2][2];
    const char* cA = (const char*)g.A + (size_t)cur.pm * tstep + (size_t)cur.kt0 * kstep; const char* cB = (const char*)g.Bt + (size_t)cur.pn * tstep + (size_t)cur.kt0 * kstep;
    S.a_ready(cur);
    if constexpr (SP2) {
        PG8_STAGE(PG8_SB(0, 0), cB, voffB); PG8_STAGE(PG8_SB(0, 1), cB + hstep, voffB); PG8_STAGE(PG8_SA(0, 0), cA, voffA); PG8_STAGE(PG8_SA(0, 1), cA + hstep, voffA);
        if (wr == 1) PG8_BAR;
        PG8_WAIT_V(2); PG8_BAR;
        PG8_STAGE(PG8_SB(1, 0), cB + kstep, voffB); PG8_STAGE(PG8_SA(1, 0), cA + kstep, voffA); PG8_STAGE(PG8_SB(1, 1), cB + hstep + kstep, voffB);
        PG8_WAIT_V(6); PG8_BAR;
    } else {
        PG8_STAGE(PG8_SB(0, 0), cB, voffB); PG8_STAGE(PG8_SA(0, 0), cA, voffA); PG8_STAGE(PG8_SB(0, 1), cB + hstep, voffB); PG8_STAGE(PG8_SA(0, 1), cA + hstep, voffA);
        if (wr == 1) PG8_BAR;
        PG8_WAIT_V(4); PG8_BAR;
        PG8_STAGE(PG8_SB(1, 0), cB + kstep, voffB); PG8_STAGE(PG8_SA(1, 0), cA + kstep, voffA); PG8_STAGE(PG8_SB(1, 1), cB + hstep + kstep, voffB);
        PG8_WAIT_V(6); PG8_BAR;
    }
    for (;;) {
        const bool has_next = S.next(ui + 1, nxt);
        const char* nA = has_next ? (const char*)g.A + (size_t)nxt.pm * tstep + (size_t)nxt.kt0 * kstep : cA; const char* nB = has_next ? (const char*)g.Bt + (size_t)nxt.pn * tstep + (size_t)nxt.kt0 * kstep : cB;
        for (int t = 0; t < nt; t += 2) {
            const bool last = (t == nt - 2);
            const char* a1 = cA + (size_t)(t + 1) * kstep;
            const char* a2 = last ? nA : cA + (size_t)(t + 2) * kstep; const char* b2 = last ? nB : cB + (size_t)(t + 2) * kstep;
            const char* a3 = a2 + kstep; const char* b3 = b2 + kstep;
            if (last && has_next) S.a_ready(nxt);
            if constexpr (SP2) {
            PG8_LDB(B0, 0, 0); PG8_LDB(B1, 0, 1); PG8_SCHED; PG8_LDA(At, 0, 0); PG8_STAGE(PG8_SA(1, 1), a1 + hstep, voffA);
            PG8_WAIT_V(8); PG8_WAIT_L(0); PG8_BAR; PG8_MMA(0, 0, At, B0); PG8_MMA(0, 1, At, B1); PG8_BAR; PG8_SCHED;
            PG8_LDA(At, 0, 1); PG8_STAGE(PG8_SB(0, 0), b2, voffB); PG8_STAGE(PG8_SB(0, 1), b2 + hstep, voffB); PG8_STAGE(PG8_SA(0, 0), a2, voffA);
            PG8_WAIT_V(8); PG8_WAIT_L(0); PG8_BAR; PG8_MMA(1, 0, At, B0); PG8_MMA(1, 1, At, B1); PG8_BAR; PG8_SCHED;
            PG8_LDB(B0, 1, 0); PG8_LDB(B1, 1, 1); PG8_SCHED; PG8_LDA(At, 1, 0); PG8_STAGE(PG8_SA(0, 1), a2 + hstep, voffA);
            PG8_WAIT_V(8); PG8_WAIT_L(0); PG8_BAR; PG8_MMA(0, 0, At, B0); PG8_MMA(0, 1, At, B1); PG8_BAR; PG8_SCHED;
            PG8_LDA(At, 1, 1); PG8_STAGE(PG8_SB(1, 0), b3, voffB); PG8_STAGE(PG8_SB(1, 1), b3 + hstep, voffB); PG8_STAGE(PG8_SA(1, 0), a3, voffA);
            PG8_WAIT_V(8); PG8_WAIT_L(0); PG8_BAR; PG8_MMA(1, 0, At, B0); PG8_MMA(1, 1, At, B1); PG8_BAR; PG8_SCHED;
            } else {
            PG8_LDB(B0, 0, 0); PG8_SCHED; PG8_LDA(At, 0, 0); PG8_STAGE(PG8_SA(1, 1), a1 + hstep, voffA);
            PG8_WAIT_L(8); PG8_BAR; PG8_WAIT_L(0); PG8_MMA(0, 0, At, B0); PG8_BAR; PG8_SCHED;
            PG8_LDB(B1, 0, 1); PG8_STAGE(PG8_SB(0, 0), b2, voffB);
            PG8_BAR; PG8_WAIT_L(0); PG8_MMA(0, 1, At, B1); PG8_BAR;
            PG8_LDA(At, 0, 1); PG8_STAGE(PG8_SA(0, 0), a2, voffA);
            PG8_BAR; PG8_WAIT_L(0); PG8_MMA(1, 0, At, B0); PG8_BAR; PG8_SCHED;
            PG8_STAGE(PG8_SB(0, 1), b2 + hstep, voffB);
            PG8_WAIT_V(6); PG8_BAR; PG8_MMA(1, 1, At, B1); PG8_BAR;
            PG8_LDB(B0, 1, 0); PG8_SCHED; PG8_LDA(At, 1, 0); PG8_STAGE(PG8_SA(0, 1), a2 + hstep, voffA);
            PG8_WAIT_L(8); PG8_BAR; PG8_WAIT_L(0); PG8_MMA(0, 0, At, B0); PG8_BAR; PG8_SCHED;
            PG8_LDB(B1, 1, 1); PG8_STAGE(PG8_SB(1, 0), b3, voffB);
            PG8_BAR; PG8_WAIT_L(0); PG8_MMA(0, 1, At, B1); PG8_BAR;
            PG8_LDA(At, 1, 1); PG8_STAGE(PG8_SA(1, 0), a3, voffA);
            PG8_BAR; PG8_WAIT_L(0); PG8_MMA(1, 0, At, B0); PG8_BAR; PG8_SCHED;
            PG8_STAGE(PG8_SB(1, 1), b3 + hstep, voffB);
            PG8_WAIT_V(6); PG8_BAR; PG8_MMA(1, 1, At, B1); PG8_BAR;
            }
        }
        if constexpr (ALIGN_EPI) { if (wr == 0) PG8_BAR; }
        if constexpr (!Epi::AFTER_DRAIN) { E(acc, cur, wr, wc, fr, fq); S.done(cur); }
        if (!has_next) break;
#pragma unroll
        for (int a = 0; a < 2; ++a)
#pragma unroll
            for (int b = 0; b < 2; ++b)
#pragma unroll
                for (int m = 0; m < 4; ++m)
#pragma unroll
                    for (int n = 0; n < 2; ++n) acc[a][b][m][n] = (f32x4){0.f, 0.f, 0.f, 0.f};
        cur = nxt; cA = nA; cB = nB; ++ui; nt = cur.nt;
        if constexpr (ALIGN_EPI) { if (wr == 1) PG8_BAR; }
    }
    PG8_WAIT_V(0);
    if constexpr (!ALIGN_EPI) { if (wr == 0) PG8_BAR; }
    PG8_BAR;
    if constexpr (Epi::AFTER_DRAIN) { E.fused(acc, cur, wr, wc, fr, fq, lds, wid, lane); S.done(cur); }
#undef PG8_SA
#undef PG8_SB
#undef PG8_STAGE
#undef PG8_LDA
#undef PG8_LDB
#undef PG8_MMA
#undef PG8_WAIT_V
#undef PG8_WAIT_L
#undef PG8_BAR
#undef PG8_SCHED
}
}
#ifndef PG8_SP2
#define PG8_SP2 true
#endif
#ifndef PG8_ALIGN
#define PG8_ALIGN true
#endif
#ifndef MK_N_LAUNCHES
#define MK_N_LAUNCHES 1
#endif
constexpr int N_LAUNCHES = MK_N_LAUNCHES;
constexpr int N_PHASES = 10;
constexpr int NWAVES = 8;

constexpr int DM = 4096, SEQ = 2048, NBP = 4, MP = NBP * SEQ, NBS = 128, LS = 8, MS = NBS * LS, M = MP + MS;
constexpr int C_Q = 0, C_K = 2048, C_V = 2560, C_Z = 3072, C_X = 5120, C_DT = 9216, LDP = 9472;
constexpr int DFF = 11008, NGU = 2 * DFF;
constexpr float EPS = 1e-6f, LOG2E = 1.4426950408889634f;

constexpr size_t O_YP = 0, O_YS = 33554432, O_PK = 37748736, O_PV = 38010880, O_PSSM = 38273024, O_PCONV = 39321600, O_PFFN = 39370752,
                 O_SK = 39458816, O_SV = 47847424, O_SSSM = 56236032, O_SCONV = 89790464, O_SFFN = 91363328, O_END = 94181376;

constexpr size_t MiB = 1u << 20;
constexpr size_t WS_CTL = 0, CTL_ZERO_BYTES = 1 * MiB;
constexpr size_t WS_W3 = 2 * MiB;
constexpr size_t WS_W4 = 174 * MiB;
constexpr size_t WS_XN = 260 * MiB;
constexpr size_t WS_W1 = 332 * MiB;
constexpr size_t WS_W2 = 406 * MiB;
constexpr size_t WS_PROJ = 438 * MiB;
constexpr size_t WS_MIX = 605 * MiB;
constexpr size_t WS_GU = 332 * MiB;
constexpr size_t WS_ACT = 719 * MiB;
constexpr size_t WS_SLAB = 332 * MiB;
constexpr size_t WS_END = 913 * MiB;
static_assert(WS_W3 + (size_t)NGU * DM * 2 <= WS_W4 && WS_W4 + (size_t)DM * DFF * 2 <= WS_XN && WS_XN + (size_t)M * DM * 2 <= WS_W1 && WS_W1 + (size_t)LDP * DM * 2 <= WS_W2 &&
              WS_W2 + (size_t)DM * DM * 2 <= WS_PROJ && WS_PROJ + (size_t)M * LDP * 2 <= WS_MIX && WS_MIX + (size_t)M * DM * 2 <= WS_ACT && WS_GU + (size_t)M * NGU * 2 <= WS_ACT &&
              WS_ACT + (size_t)M * DFF * 2 <= WS_END, "d_ws map");

constexpr int CW_TMO = 0, CW_CODE = 1, CW_BAR = 4096, CW_Q = 8192  , CW_SSQ = 16384  ;

constexpr int RING_OFF = 0, RING_BYTES = 131072;
constexpr int TB_OFF = 131072;
constexpr int CWL_OFF = TB_OFF + 8192;
constexpr int LDSCTL_OFF = CWL_OFF + 6400, MISC_OFF = LDSCTL_OFF + 320;
constexpr int LDS_BYTES = 147456;
static_assert(MISC_OFF + 128 <= LDS_BYTES && (MISC_OFF % 16) == 0, "LDS map");

#define GAS __attribute__((address_space(1)))
#define LAS __attribute__((address_space(3)))
typedef unsigned short bf16;
typedef unsigned u32x4 __attribute__((ext_vector_type(4)));
typedef unsigned u32x2 __attribute__((ext_vector_type(2)));
typedef float f32x4 __attribute__((ext_vector_type(4)));
typedef float f32x16 __attribute__((ext_vector_type(16)));
typedef short bf16x8 __attribute__((ext_vector_type(8)));
typedef short s16x4 __attribute__((ext_vector_type(4)));
typedef short v4i16_t __attribute__((ext_vector_type(4)));
typedef GAS unsigned gu32;
#define RLX_AGENT __ATOMIC_RELAXED, __HIP_MEMORY_SCOPE_AGENT
#define LDS_WAIT() asm volatile("s_waitcnt lgkmcnt(0)" ::: "memory")
#define VM_WAIT() asm volatile("s_waitcnt vmcnt(0)" ::: "memory")
#define MFMA32(a, b, c) __builtin_amdgcn_mfma_f32_32x32x16_bf16((a), (b), (c), 0, 0, 0)
typedef float f32x2_t __attribute__((ext_vector_type(2)));
typedef __bf16 bf16x2_t __attribute__((ext_vector_type(2)));
__device__ __forceinline__ unsigned cvtpk(float lo, float hi) { f32x2_t v = {lo, hi}; bf16x2_t b = __builtin_convertvector(v, bf16x2_t); return __builtin_bit_cast(unsigned, b); }
__device__ __forceinline__ float bf2f(unsigned short h) { return __uint_as_float((unsigned)h << 16); }
__device__ __forceinline__ float bflo(unsigned w) { return __uint_as_float(w << 16); }
__device__ __forceinline__ float bfhi(unsigned w) { return __uint_as_float(w & 0xffff0000u); }
__device__ __forceinline__ void unpack8(const u32x4 w, float (&f)[8]) { f[0] = bflo(w.x); f[1] = bfhi(w.x); f[2] = bflo(w.y); f[3] = bfhi(w.y); f[4] = bflo(w.z); f[5] = bfhi(w.z); f[6] = bflo(w.w); f[7] = bfhi(w.w); }
__device__ __forceinline__ u32x4 pack8(const float (&f)[8]) { u32x4 w; w.x = cvtpk(f[0], f[1]); w.y = cvtpk(f[2], f[3]); w.z = cvtpk(f[4], f[5]); w.w = cvtpk(f[6], f[7]); return w; }
__device__ __forceinline__ float silu_f(float x) { return x * __builtin_amdgcn_rcpf(1.0f + __expf(-x)); }
__device__ __forceinline__ float softplus_f(float x) { return x > 20.f ? x : log1pf(__expf(x)); }
__device__ __forceinline__ int crow(int r, int hi) { return (r & 3) + 8 * (r >> 2) + 4 * hi; }
__device__ __forceinline__ s16x4 vtr(const LAS unsigned char* p) { return __builtin_bit_cast(s16x4, __builtin_amdgcn_ds_read_tr16_b64_v4i16((LAS v4i16_t*)p)); }
__device__ __forceinline__ bf16x8 cat4(s16x4 a, s16x4 b) { bf16x8 r; r[0] = a[0]; r[1] = a[1]; r[2] = a[2]; r[3] = a[3]; r[4] = b[0]; r[5] = b[1]; r[6] = b[2]; r[7] = b[3]; return r; }
__device__ __forceinline__ bf16x8 pack_step(const f32x16& x, int s) {
    u32x4 p; p.x = cvtpk(x[8 * s], x[8 * s + 1]); p.y = cvtpk(x[8 * s + 2], x[8 * s + 3]); p.z = cvtpk(x[8 * s + 4], x[8 * s + 5]); p.w = cvtpk(x[8 * s + 6], x[8 * s + 7]);
    return __builtin_bit_cast(bf16x8, p);
}
__device__ __forceinline__ float wave_sum(float v) {
#pragma unroll
    for (int o = 1; o < 64; o <<= 1) v += __shfl_xor(v, o);
    return v;
}

struct Args { const float* in[26]; float* out; unsigned char* ws; int ph_lo, ph_hi, grid, pad; };
#define KARG ((const __attribute__((address_space(4))) Args*)__builtin_amdgcn_kernarg_segment_ptr())
#define P_x_prompt (KARG->in[0])
#define P_x_sample (KARG->in[1])
#define P_st_k (KARG->in[2])
#define P_st_v (KARG->in[3])
#define P_st_ssm (KARG->in[4])
#define P_st_conv (KARG->in[5])
#define P_st_ffn (KARG->in[6])
#define P_rel_bias (KARG->in[7])
#define P_mix_nw (KARG->in[8])
#define P_w_in (KARG->in[9])
#define P_q_nw (KARG->in[10])
#define P_k_nw (KARG->in[11])
#define P_sinks (KARG->in[12])
#define P_conv_w (KARG->in[13])
#define P_conv_b (KARG->in[14])
#define P_dt_bias (KARG->in[15])
#define P_A_log (KARG->in[16])
#define P_Dv (KARG->in[17])
#define P_ssd_nw (KARG->in[18])
#define P_w_out (KARG->in[19])
#define P_ffn_nw (KARG->in[20])
#define P_w_gate (KARG->in[21])
#define P_w_up (KARG->in[22])
#define P_fconv_w (KARG->in[23])
#define P_fconv_b (KARG->in[24])
#define P_w_down (KARG->in[25])
#define P_out (KARG->out)
#define P_ws (KARG->ws)
#define P_W1 ((bf16*)(P_ws + WS_W1))
#define P_W2 ((bf16*)(P_ws + WS_W2))
#define P_W3 ((bf16*)(P_ws + WS_W3))
#define P_W4 ((bf16*)(P_ws + WS_W4))
#define P_XN ((bf16*)(P_ws + WS_XN))
#define P_PROJ ((bf16*)(P_ws + WS_PROJ))
#define P_MIX ((bf16*)(P_ws + WS_MIX))
#define P_GU ((bf16*)(P_ws + WS_GU))
#define P_ACT ((bf16*)(P_ws + WS_ACT))
#define P_ctl ((gu32*)(P_ws + WS_CTL))
#define P_ssq ((float*)(P_ws + WS_CTL) + CW_SSQ)
struct Ptrs {};
#define XB_TMO      128
#define XB_XCNT(j)  (256  + 64 * (j))
#define XB_XSUB(j)  (1280 + 64 * (j))
#define XB_XGEN(j)  (2304 + 64 * (j))
#define XB_TOP      3328
#define XB_TOPGEN   3392
#define XCD_BAR_WORDS 3456
#define XB_SPIN_CAP (1u << 18)

__device__ __forceinline__ unsigned xb_ld(unsigned* p)              { return __hip_atomic_load(p, __ATOMIC_RELAXED, __HIP_MEMORY_SCOPE_AGENT); }
__device__ __forceinline__ unsigned xb_add(unsigned* p, unsigned v) { return __hip_atomic_fetch_add(p, v, __ATOMIC_RELAXED, __HIP_MEMORY_SCOPE_AGENT); }
__device__ __forceinline__ unsigned xb_xcc_id() { return (unsigned)__builtin_amdgcn_s_getreg((3 << 11) | 20) & 0xFu; }
#define XB_SPIN(cond, bar) do { unsigned _sp = 0; while (cond) { __builtin_amdgcn_s_sleep(1); \
    if ((++_sp & 255u) == 0u) { if (xb_ld(&(bar)[XB_TMO])) break; if (_sp > XB_SPIN_CAP) { atomicAdd(&(bar)[XB_TMO], 1u); break; } } } } while (0)

struct XcdBarrier {
    unsigned* bar; unsigned x;
    volatile LAS unsigned* st;
};

__device__ __forceinline__ XcdBarrier xcd_barrier_post(unsigned* bar, volatile LAS unsigned* st) {
    XcdBarrier b; b.bar = bar; b.x = xb_xcc_id(); b.st = st;
    if (threadIdx.x == 0) (void)xb_add(&bar[XB_XCNT(b.x)], 1u);
    return b;
}
__device__ __forceinline__ void xcd_barrier_complete(unsigned* bar, unsigned x, unsigned& nloc, unsigned& nx) {
    const unsigned G = (unsigned)KARG->grid;
    unsigned sum, cnt, mine, sp = 0u;
    for (;;) {
        sum = 0u; cnt = 0u; mine = 0u;
#pragma unroll
        for (unsigned j = 0; j < 16; ++j) { const unsigned c = xb_ld(&bar[XB_XCNT(j)]); sum += c; cnt += (c > 0u) ? 1u : 0u; mine = (j == x) ? c : mine; }
        if (sum == G) break;
        __builtin_amdgcn_s_sleep(1);
        if ((++sp & 255u) == 0u) { if (xb_ld(&bar[XB_TMO])) break; if (sp > XB_SPIN_CAP) { atomicAdd(&bar[XB_TMO], 1u); break; } }
    }
    nloc = mine > 0u ? mine : 1u; nx = cnt > 0u ? cnt : 1u;
}

__device__ __forceinline__ void xcd_barrier(const XcdBarrier& b) {
    asm volatile("s_waitcnt vmcnt(0)" ::: "memory");
    __syncthreads();
    if (threadIdx.x == 0) {
        unsigned* bar = b.bar;
        __builtin_amdgcn_s_waitcnt(0);
        unsigned nloc = b.st[0], nx = b.st[1];
        if (nloc == 0u) { xcd_barrier_complete(bar, b.x, nloc, nx); b.st[0] = nloc; b.st[1] = nx; }
        const unsigned old = xb_add(&bar[XB_XSUB(b.x)], 1u);
        const unsigned gen = old / nloc;
        if (old + 1u == (gen + 1u) * nloc) {
            __builtin_amdgcn_fence(__ATOMIC_RELEASE, "agent");
            asm volatile("s_waitcnt vmcnt(0)" ::: "memory");
            const unsigned og = xb_add(&bar[XB_TOP], 1u);
            const unsigned tg = og / nx;
            if (og + 1u == (tg + 1u) * nx) xb_add(&bar[XB_TOPGEN], 1u);
            else XB_SPIN(xb_ld(&bar[XB_TOPGEN]) == tg, bar);
            __builtin_amdgcn_fence(__ATOMIC_ACQUIRE, "agent");
            xb_add(&bar[XB_XGEN(b.x)], 1u);
            asm volatile("s_waitcnt vmcnt(0)" ::: "memory");
        } else {
            XB_SPIN(xb_ld(&bar[XB_XGEN(b.x)]) == gen, bar);
            __builtin_amdgcn_fence(__ATOMIC_ACQUIRE, "agent");
            asm volatile("s_waitcnt vmcnt(0)" ::: "memory");
        }
    }
    __syncthreads();
}


struct Frame { LAS unsigned char* lds; int tid, lane, wave, G, bid; };

__device__ __forceinline__ int wq_next(gu32* ctr, volatile LAS unsigned* slot, int tid) {
    __syncthreads();
    if (tid == 0) *slot = __hip_atomic_fetch_add(ctr, 1u, RLX_AGENT);
    __syncthreads();
    return (int)*slot;
}

__device__ __forceinline__ void p0_transpose_item(const float* W, int K, int N, bf16* WT, int mode, LAS float* scr, int item, int lane) {
    const int nblk = N / 32, kb = item / nblk, nb = item % nblk, k0 = 64 * kb, n0 = 32 * nb;
    const int rb = (mode == 0) ? n0 : ((n0 >> 7) * 256 + (n0 & 127) + (mode == 2 ? 128 : 0));
#pragma unroll 8
    for (int i = 0; i < 32; ++i) { const int kk = 2 * i + (lane >> 5); scr[kk * 33 + (lane & 31)] = W[(size_t)(k0 + kk) * N + n0 + (lane & 31)]; }
    LDS_WAIT(); asm volatile("" ::: "memory");
    const int c = lane & 7;
#pragma unroll
    for (int j = 0; j < 4; ++j) { const int n = (lane >> 3) + 8 * j; const LAS float* s = scr + (8 * c) * 33 + n;
        u32x4 o; o.x = cvtpk(s[0 * 33], s[1 * 33]); o.y = cvtpk(s[2 * 33], s[3 * 33]); o.z = cvtpk(s[4 * 33], s[5 * 33]); o.w = cvtpk(s[6 * 33], s[7 * 33]);
        *(u32x4*)(WT + (size_t)(rb + n) * K + k0 + 8 * c) = o; }
    LDS_WAIT(); asm volatile("" ::: "memory");
}
__device__ __forceinline__ void rms_regs_to_bf16(const f32x4 (&v)[16], const float* w, bf16* orow, int lane) {
    float s = 0.f;
#pragma unroll
    for (int j = 0; j < 16; ++j) s += (v[j].x * v[j].x + v[j].y * v[j].y) + (v[j].z * v[j].z + v[j].w * v[j].w);
    const float rstd = 1.0f / sqrtf(wave_sum(s) * (1.0f / DM) + EPS);
    const f32x4* wr = (const f32x4*)w + lane; u32x2* o8 = (u32x2*)orow + lane;
#pragma unroll
    for (int j = 0; j < 16; ++j) { const f32x4 wv = wr[64 * j]; u32x2 o; o.x = cvtpk(v[j].x * rstd * wv.x, v[j].y * rstd * wv.y); o.y = cvtpk(v[j].z * rstd * wv.z, v[j].w * rstd * wv.w); o8[64 * j] = o; }
}
__device__ __forceinline__ void rms_row_to_bf16(const float* xrow, const float* w, bf16* orow, int lane) {
    const f32x4* xr = (const f32x4*)xrow + lane; f32x4 v[16];
#pragma unroll
    for (int j = 0; j < 16; ++j) v[j] = xr[64 * j];
    rms_regs_to_bf16(v, w, orow, lane);
}
constexpr int I_1 = (DM / 64) * (9248 / 32), I_2 = (DM / 64) * (DM / 32), I_3 = (DM / 64) * (DFF / 32), I_4 = (DFF / 64) * (DM / 32);
template <int WHICH> __device__ __forceinline__ void convert_weights(const Frame& F, int gw, int ngw) {
    LAS float* scr = (LAS float*)(F.lds + RING_OFF + F.wave * 16384);
    constexpr int NIT = WHICH == 0 ? I_1 + I_2 : (WHICH == 3 ? 2 * I_3 : I_4);
    for (int it = gw; it < NIT; it += ngw) {
        if (WHICH == 0) { if (it < I_1) p0_transpose_item(P_w_in, DM, 9248, P_W1, 0, scr, it, F.lane); else p0_transpose_item(P_w_out, DM, DM, P_W2, 0, scr, it - I_1, F.lane); }
        else if (WHICH == 3) { if (it < I_3) p0_transpose_item(P_w_gate, DM, DFF, P_W3, 1, scr, it, F.lane); else p0_transpose_item(P_w_up, DM, DFF, P_W3, 2, scr, it - I_3, F.lane); }
        else p0_transpose_item(P_w_down, DFF, DM, P_W4, 0, scr, it, F.lane);
    }
}
template <int WHICH> __device__ __forceinline__ void tail_filler(const Frame& F, int nunits) {
    const int extra = nunits % F.G; const int first = extra, nhelp = F.G - extra;
    if (F.bid >= first) convert_weights<WHICH>(F, (F.bid - first) * NWAVES + F.wave, nhelp * NWAVES);
}
__device__ __forceinline__ void p0_prologue(const Frame& F, const Ptrs& P) {
    const int gw = F.bid * NWAVES + F.wave, NGW = F.G * NWAVES;
    convert_weights<0>(F, gw, NGW);
    for (int m = gw; m < M; m += NGW) { const float* xr = (m < MP) ? P_x_prompt + (size_t)m * DM : P_x_sample + (size_t)(m - MP) * DM; rms_row_to_bf16(xr, P_mix_nw, P_XN + (size_t)m * DM, F.lane); }
}

#ifndef NREP_P0
#define NREP_P0 1
#endif
#ifndef NREP_MIX
#define NREP_MIX 1
#endif
#if NREP_MIX > 1
#define SSQ_REP_OFF (*(volatile LAS unsigned*)(F.lds + MISC_OFF + 20))
#else
#define SSQ_REP_OFF 0
#endif
constexpr int KS = 272, VS = 320;
__device__ __forceinline__ int t5_bucket(int n) { if (n < 16) return n; const float v = logf((float)n / 16.0f) / 2.0794415f * 16.0f; const int l = 16 + (int)v; return l < 31 ? l : 31; }

__device__ __forceinline__ void attn_task(const LAS unsigned char* Kl, const LAS unsigned char* Vl, int kt0, const bf16x8 (&qf)[8], int d0, int jmin, const LAS float* tb, float sink2, bf16* outp, int lane) {
    const int q = lane & 31, hi = lane >> 5;
    asm volatile("" : "+v"(d0));
    f32x16 st[5];
#pragma unroll
    for (int t = 0; t < 5; ++t) {
        f32x16 a; for (int i = 0; i < 16; ++i) a[i] = 0.f;
        const LAS unsigned char* kp = Kl + ((kt0 + t) * 32 + q) * KS + hi * 16;
#pragma unroll
        for (int ks = 0; ks < 8; ++ks) a = MFMA32(*(const LAS bf16x8*)(kp + ks * 32), qf[ks], a);
        st[t] = a; __builtin_amdgcn_sched_barrier(0);
    }
    float mx = sink2;
#pragma unroll
    for (int t = 0; t < 5; ++t)
#pragma unroll
        for (int r = 0; r < 16; ++r) { const int jj = 32 * t + crow(r, hi); const int dist = d0 - jj; const bool ok = ((unsigned)dist < 128u) && (jj >= jmin);
            float bv = tb[dist & 127]; asm volatile("" : "+v"(bv)); const float s = ok ? st[t][r] + bv : -__builtin_inff(); st[t][r] = s; mx = fmaxf(mx, s); }
    mx = fmaxf(mx, __shfl_xor(mx, 32));
    float l = 0.f;
#pragma unroll
    for (int t = 0; t < 5; ++t)
#pragma unroll
        for (int r = 0; r < 16; ++r) { const float p = __builtin_amdgcn_exp2f(st[t][r] - mx); st[t][r] = p; l += p; }
    l += __shfl_xor(l, 32); l += __builtin_amdgcn_exp2f(sink2 - mx);
    const float inv = 1.0f / l;
    f32x16 ot[4];
#pragma unroll
    for (int d = 0; d < 4; ++d) for (int i = 0; i < 16; ++i) ot[d][i] = 0.f;
    const int g4 = lane >> 4, i16 = lane & 15;
    const LAS unsigned char* vp = Vl + (kt0 * 32 + 4 * hi + (i16 >> 2)) * VS + ((g4 & 1) * 16 + (i16 & 3) * 4) * 2;
#pragma unroll
    for (int t = 0; t < 5; ++t)
#pragma unroll
        for (int s2 = 0; s2 < 2; ++s2) { const bf16x8 pf = pack_step(st[t], s2);
#pragma unroll
            for (int d = 0; d < 4; ++d) { const LAS unsigned char* a = vp + (t * 32 + s2 * 16) * VS + d * 64; const bf16x8 vf = cat4(vtr(a), vtr(a + 8 * VS)); ot[d] = MFMA32(vf, pf, ot[d]); } __builtin_amdgcn_sched_barrier(0); }
#pragma unroll
    for (int d = 0; d < 4; ++d)
#pragma unroll
        for (int r4 = 0; r4 < 4; ++r4) { u32x2 w; w.x = cvtpk(ot[d][4 * r4] * inv, ot[d][4 * r4 + 1] * inv); w.y = cvtpk(ot[d][4 * r4 + 2] * inv, ot[d][4 * r4 + 3] * inv);
            *(u32x2*)(outp + 32 * d + 8 * r4 + 4 * hi) = w; }
}
__device__ __forceinline__ void load_q(const bf16* qp, const float* qnw, int hi, bf16x8 (&qf)[8]) {
    u32x4 qw[8]; float ss = 0.f;
#pragma unroll
    for (int ks = 0; ks < 8; ++ks) { qw[ks] = *(const u32x4*)(qp + 16 * ks); float f[8]; unpack8(qw[ks], f);
#pragma unroll
        for (int i = 0; i < 8; ++i) ss += f[i] * f[i]; }
    ss += __shfl_xor(ss, 32);
    const float sc = (1.0f / sqrtf(ss * (1.0f / 128.0f) + EPS)) * 0.08838834764831845f * LOG2E;
#pragma unroll
    for (int ks = 0; ks < 8; ++ks) { float f[8]; unpack8(qw[ks], f); const f32x4 w0 = *(const f32x4*)(qnw + 16 * ks + 8 * hi), w1 = *(const f32x4*)(qnw + 16 * ks + 8 * hi + 4);
        f[0] *= sc * w0.x; f[1] *= sc * w0.y; f[2] *= sc * w0.z; f[3] *= sc * w0.w; f[4] *= sc * w1.x; f[5] *= sc * w1.y; f[6] *= sc * w1.z; f[7] *= sc * w1.w;
        qf[ks] = __builtin_bit_cast(bf16x8, pack8(f)); }
}
__device__ __forceinline__ float red16(float v) { v += __shfl_xor(v, 1); v += __shfl_xor(v, 2); v += __shfl_xor(v, 4); v += __shfl_xor(v, 8); return v; }

__device__ __forceinline__ void attn_prompt_unit(const Frame& F, const Ptrs& P, int unit) {
    const int kvh = unit & 3, qb = (unit >> 2) & 31, b = unit >> 7, t0 = 64 * qb, rowb = b * SEQ;
    LAS unsigned char* Kl = F.lds + RING_OFF; LAS unsigned char* Vl = Kl + 192 * KS;
    for (int task = F.tid; task < 192 * 16; task += 512) {
        const int r = task >> 4, ch = task & 15, pos = t0 - 128 + r;
        u32x4 kw = (u32x4){0u, 0u, 0u, 0u}, vw = kw;
        if (pos >= 0) { const bf16* pr = P_PROJ + (size_t)(rowb + pos) * LDP + kvh * 128 + ch * 8; kw = *(const u32x4*)(pr + C_K); vw = *(const u32x4*)(pr + C_V); }
        float kf[8]; unpack8(kw, kf); float ss = 0.f;
#pragma unroll
        for (int i = 0; i < 8; ++i) ss += kf[i] * kf[i];
        ss = red16(ss);
        const float rstd = 1.0f / sqrtf(ss * (1.0f / 128.0f) + EPS);
        const f32x4 w0 = *(const f32x4*)(P_k_nw + ch * 8), w1 = *(const f32x4*)(P_k_nw + ch * 8 + 4);
        kf[0] *= rstd * w0.x; kf[1] *= rstd * w0.y; kf[2] *= rstd * w0.z; kf[3] *= rstd * w0.w; kf[4] *= rstd * w1.x; kf[5] *= rstd * w1.y; kf[6] *= rstd * w1.z; kf[7] *= rstd * w1.w;
        *(LAS u32x4*)(Kl + r * KS + ch * 16) = pack8(kf);
        *(LAS u32x4*)(Vl + r * VS + ch * 16) = vw;
        if (t0 >= SEQ - 128 && r >= 128) {
            const size_t o = (((size_t)b * 128 + (pos - (SEQ - 128))) * 4 + kvh) * 128 + ch * 8; float vf[8]; unpack8(vw, vf);
            *(f32x4*)(P_out + O_PK + o) = (f32x4){kf[0], kf[1], kf[2], kf[3]}; *(f32x4*)(P_out + O_PK + o + 4) = (f32x4){kf[4], kf[5], kf[6], kf[7]};
            *(f32x4*)(P_out + O_PV + o) = (f32x4){vf[0], vf[1], vf[2], vf[3]}; *(f32x4*)(P_out + O_PV + o + 4) = (f32x4){vf[4], vf[5], vf[6], vf[7]};
        }
    }
    __builtin_amdgcn_sched_barrier(0);
    const int q = F.lane & 31, hi = F.lane >> 5, g = F.wave >> 1, sub = F.wave & 1, head = kvh * 4 + g;
    const int row = rowb + t0 + 32 * sub + q;
    bf16x8 qf[8]; load_q(P_PROJ + (size_t)row * LDP + C_Q + head * 128 + 8 * hi, P_q_nw, hi, qf);
    __syncthreads();
    attn_task(Kl, Vl, sub, qf, 128 + q, 128 - t0 - 32 * sub, (const LAS float*)(F.lds + TB_OFF) + head * 128, P_sinks[head] * LOG2E, P_MIX + (size_t)row * DM + head * 128, F.lane);
}
__device__ __forceinline__ void attn_sample_unit(const Frame& F, const Ptrs& P, int unit) {
    const int kvh = unit & 3, b = unit >> 2;
    LAS unsigned char* Kl = F.lds + RING_OFF; LAS unsigned char* Vl = Kl + 160 * KS;
    for (int task = F.tid; task < 160 * 16; task += 512) {
        const int r = task >> 4, ch = task & 15;
        float kf[8], vf[8];
#pragma unroll
        for (int i = 0; i < 8; ++i) { kf[i] = 0.f; vf[i] = 0.f; }
        if (r < 128) {
            const size_t o = (((size_t)b * 128 + r) * 4 + kvh) * 128 + ch * 8;
            const f32x4 a0 = *(const f32x4*)(P_st_k + o), a1 = *(const f32x4*)(P_st_k + o + 4), c0 = *(const f32x4*)(P_st_v + o), c1 = *(const f32x4*)(P_st_v + o + 4);
            kf[0] = a0.x; kf[1] = a0.y; kf[2] = a0.z; kf[3] = a0.w; kf[4] = a1.x; kf[5] = a1.y; kf[6] = a1.z; kf[7] = a1.w;
            vf[0] = c0.x; vf[1] = c0.y; vf[2] = c0.z; vf[3] = c0.w; vf[4] = c1.x; vf[5] = c1.y; vf[6] = c1.z; vf[7] = c1.w;
            if (r >= 8) { const size_t o2 = o - (size_t)8 * 4 * 128; *(f32x4*)(P_out + O_SK + o2) = a0; *(f32x4*)(P_out + O_SK + o2 + 4) = a1; *(f32x4*)(P_out + O_SV + o2) = c0; *(f32x4*)(P_out + O_SV + o2 + 4) = c1; }
        } else if (r < 136) {
            const bf16* pr = P_PROJ + (size_t)(MP + b * 8 + (r - 128)) * LDP + kvh * 128 + ch * 8;
            unpack8(*(const u32x4*)(pr + C_K), kf); unpack8(*(const u32x4*)(pr + C_V), vf);
        }
        float ss = 0.f;
#pragma unroll
        for (int i = 0; i < 8; ++i) ss += kf[i] * kf[i];
        ss = red16(ss);
        if (r >= 128 && r < 136) {
            const float rstd = 1.0f / sqrtf(ss * (1.0f / 128.0f) + EPS);
            const f32x4 w0 = *(const f32x4*)(P_k_nw + ch * 8), w1 = *(const f32x4*)(P_k_nw + ch * 8 + 4);
            kf[0] *= rstd * w0.x; kf[1] *= rstd * w0.y; kf[2] *= rstd * w0.z; kf[3] *= rstd * w0.w; kf[4] *= rstd * w1.x; kf[5] *= rstd * w1.y; kf[6] *= rstd * w1.z; kf[7] *= rstd * w1.w;
            const size_t o2 = (((size_t)b * 128 + 120 + (r - 128)) * 4 + kvh) * 128 + ch * 8;
            *(f32x4*)(P_out + O_SK + o2) = (f32x4){kf[0], kf[1], kf[2], kf[3]}; *(f32x4*)(P_out + O_SK + o2 + 4) = (f32x4){kf[4], kf[5], kf[6], kf[7]};
            *(f32x4*)(P_out + O_SV + o2) = (f32x4){vf[0], vf[1], vf[2], vf[3]}; *(f32x4*)(P_out + O_SV + o2 + 4) = (f32x4){vf[4], vf[5], vf[6], vf[7]};
        }
        *(LAS u32x4*)(Kl + r * KS + ch * 16) = pack8(kf);
        *(LAS u32x4*)(Vl + r * VS + ch * 16) = pack8(vf);
    }
    __syncthreads();
    if (F.wave == 0) {
        const int q = F.lane & 31, hi = F.lane >> 5, g = q >> 3, i = q & 7, head = kvh * 4 + g, row = MP + b * 8 + i;
        bf16x8 qf[8]; load_q(P_PROJ + (size_t)row * LDP + C_Q + head * 128 + 8 * hi, P_q_nw, hi, qf);
        attn_task(Kl, Vl, 0, qf, 128 + i, 0, (const LAS float*)(F.lds + TB_OFF) + head * 128, P_sinks[head] * LOG2E, P_MIX + (size_t)row * DM + head * 128, F.lane);
    }
}

constexpr int XSTR = 144, BSTR = 272;
constexpr int L_XS = 0, L_XW = 18432, L_BS = 36864, L_CS = 71680, L_HS = 106496, L_ACS = 123904, L_DTV = 124416;
__device__ __forceinline__ void conv4_8(const bf16* src, int pos, const LAS float* cw, float (&o)[8], u32x4& center) {
    float acc[8];
#pragma unroll
    for (int i = 0; i < 8; ++i) acc[i] = cw[4 * 320 + i];
#pragma unroll
    for (int k = 0; k < 4; ++k) { u32x4 w = (u32x4){0u, 0u, 0u, 0u}; if (pos - 3 + k >= 0) w = *(const u32x4*)(src + (long)(k - 3) * LDP); if (k == 3) center = w;
        float f[8]; unpack8(w, f);
#pragma unroll
        for (int i = 0; i < 8; ++i) acc[i] += cw[k * 320 + i] * f[i]; }
#pragma unroll
    for (int i = 0; i < 8; ++i) o[i] = silu_f(acc[i]);
}
__device__ __forceinline__ void store8f(float* p, const u32x4 w) { float f[8]; unpack8(w, f); *(f32x4*)p = (f32x4){f[0], f[1], f[2], f[3]}; *(f32x4*)(p + 4) = (f32x4){f[4], f[5], f[6], f[7]}; }

__device__ __forceinline__ void ssd_prompt_unit(const Frame& F, const Ptrs& P, int unit) {
    const int h = unit & 31, b = unit >> 5, grp = h >> 2, rowb0 = b * SEQ;
    LAS unsigned char* L = F.lds + RING_OFF;
    LAS float* CWL = (LAS float*)(F.lds + CWL_OFF); LAS float* ACS = (LAS float*)(L + L_ACS); LAS float* DTV = (LAS float*)(L + L_DTV);
    for (int i = F.tid; i < 5 * 320; i += 512) { const int k = i / 320, ci = i % 320; const int ch = ci < 64 ? h * 64 + ci : (ci < 192 ? 2048 + grp * 128 + (ci - 64) : 3072 + grp * 128 + (ci - 192));
        CWL[i] = k < 4 ? P_conv_w[k * 4096 + ch] : P_conv_b[ch]; }
    for (int i = F.tid; i < 64 * BSTR / 4; i += 512) ((LAS unsigned*)(L + L_HS))[i] = 0u;
    f32x16 hacc; for (int i = 0; i < 16; ++i) hacc[i] = 0.f;
    const float Ah = -__expf(P_A_log[h]), Dh = P_Dv[h], dtb = P_dt_bias[h];
    const int q = F.lane & 31, hi = F.lane >> 5, g4 = F.lane >> 4, i16 = F.lane & 15;
    for (int c = 0; c < 16; ++c) {
        __syncthreads();
        const int rowb = rowb0 + 128 * c;
        if (F.wave == 0) {
            const int ta = 2 * F.lane;
            const float dv0 = softplus_f(bf2f(P_PROJ[(size_t)(rowb + ta) * LDP + C_DT + h]) + dtb), dv1 = softplus_f(bf2f(P_PROJ[(size_t)(rowb + ta + 1) * LDP + C_DT + h]) + dtb);
            const float a0 = dv0 * Ah, a1 = dv1 * Ah; float s = a0 + a1;
#pragma unroll
            for (int off = 1; off < 64; off <<= 1) { const float t = __shfl_up(s, off); if (F.lane >= off) s += t; }
            ACS[ta] = s - a1; ACS[ta + 1] = s; DTV[ta] = dv0; DTV[ta + 1] = dv1;
        }
        for (int task = F.tid; task < 1024; task += 512) { const int l = task >> 3, cc = task & 7; float o[8]; u32x4 ctr;
            conv4_8(P_PROJ + (size_t)(rowb + l) * LDP + C_X + h * 64 + cc * 8, 128 * c + l, CWL + cc * 8, o, ctr);
            *(LAS u32x4*)(L + L_XS + l * XSTR + cc * 16) = pack8(o);
            if (c == 15 && l >= 125) store8f(P_out + O_PCONV + ((size_t)b * 3 + (l - 125)) * 4096 + h * 64 + cc * 8, ctr); }
        for (int task = F.tid; task < 2048; task += 512) { const int l = task >> 4, cc = task & 15; float o[8]; u32x4 ctr;
            conv4_8(P_PROJ + (size_t)(rowb + l) * LDP + C_X + 2048 + grp * 128 + cc * 8, 128 * c + l, CWL + 64 + cc * 8, o, ctr);
            *(LAS u32x4*)(L + L_BS + l * BSTR + cc * 16) = pack8(o);
            if (c == 15 && l >= 125 && (h & 3) == 0) store8f(P_out + O_PCONV + ((size_t)b * 3 + (l - 125)) * 4096 + 2048 + grp * 128 + cc * 8, ctr); }
        for (int task = F.tid; task < 2048; task += 512) { const int l = task >> 4, cc = task & 15; float o[8]; u32x4 ctr;
            conv4_8(P_PROJ + (size_t)(rowb + l) * LDP + C_X + 3072 + grp * 128 + cc * 8, 128 * c + l, CWL + 192 + cc * 8, o, ctr);
            *(LAS u32x4*)(L + L_CS + l * BSTR + cc * 16) = pack8(o);
            if (c == 15 && l >= 125 && (h & 3) == 0) store8f(P_out + O_PCONV + ((size_t)b * 3 + (l - 125)) * 4096 + 3072 + grp * 128 + cc * 8, ctr); }
        __syncthreads();
        const float acs_end = ACS[127];
        for (int task = F.tid; task < 1024; task += 512) { const int l = task >> 3, cc = task & 7; float f[8]; unpack8(*(const LAS u32x4*)(L + L_XS + l * XSTR + cc * 16), f);
            const float sc = DTV[l] * __expf(acs_end - ACS[l]);
#pragma unroll
            for (int i = 0; i < 8; ++i) f[i] *= sc;
            *(LAS u32x4*)(L + L_XW + l * XSTR + cc * 16) = pack8(f); }
        __syncthreads();
        {
            const int pt = F.wave & 1, lt = F.wave >> 1, l = 32 * lt + q;
            bf16x8 cf[8];
#pragma unroll
            for (int ks = 0; ks < 8; ++ks) cf[ks] = *(const LAS bf16x8*)(L + L_CS + l * BSTR + ks * 32 + hi * 16);
            f32x16 y; for (int i = 0; i < 16; ++i) y[i] = 0.f;
            if (c > 0) {
#pragma unroll
                for (int ks = 0; ks < 8; ++ks) y = MFMA32(*(const LAS bf16x8*)(L + L_HS + (32 * pt + q) * BSTR + ks * 32 + hi * 16), cf[ks], y);
            }
            const float acs_l = ACS[l], ea = __expf(acs_l);
#pragma unroll
            for (int i = 0; i < 16; ++i) y[i] *= ea;
            for (int st = 0; st <= lt; ++st) {
                f32x16 g; for (int i = 0; i < 16; ++i) g[i] = 0.f;
#pragma unroll
                for (int ks = 0; ks < 8; ++ks) g = MFMA32(*(const LAS bf16x8*)(L + L_BS + (32 * st + q) * BSTR + ks * 32 + hi * 16), cf[ks], g);
#pragma unroll
                for (int r = 0; r < 16; ++r) { const int s = 32 * st + crow(r, hi); g[r] = (s <= l) ? g[r] * __expf(acs_l - ACS[s]) * DTV[s] : 0.f; }
#pragma unroll
                for (int s2 = 0; s2 < 2; ++s2) { const bf16x8 pf = pack_step(g, s2);
                    const LAS unsigned char* a = L + L_XS + (32 * st + 16 * s2 + 4 * hi + (i16 >> 2)) * XSTR + (32 * pt + (g4 & 1) * 16 + (i16 & 3) * 4) * 2;
                    y = MFMA32(cat4(vtr(a), vtr(a + 8 * XSTR)), pf, y); }
            }
            const int row = rowb + l; const bf16* zp = P_PROJ + (size_t)row * LDP + C_Z + h * 64 + 32 * pt + 4 * hi; float ssq = 0.f;
#pragma unroll
            for (int r4 = 0; r4 < 4; ++r4) { const u32x2 zw = *(const u32x2*)(zp + 8 * r4); const u32x2 xw = *(const LAS u32x2*)(L + L_XS + l * XSTR + (32 * pt + 8 * r4 + 4 * hi) * 2);
                const f32x4 nw = *(const f32x4*)(P_ssd_nw + h * 64 + 32 * pt + 8 * r4 + 4 * hi);
                const float z0 = bflo(zw.x), z1 = bfhi(zw.x), z2 = bflo(zw.y), z3 = bfhi(zw.y);
                const float g0 = (y[4 * r4] + Dh * bflo(xw.x)) * silu_f(z0), g1 = (y[4 * r4 + 1] + Dh * bfhi(xw.x)) * silu_f(z1), g2 = (y[4 * r4 + 2] + Dh * bflo(xw.y)) * silu_f(z2), g3 = (y[4 * r4 + 3] + Dh * bfhi(xw.y)) * silu_f(z3);
                ssq += (g0 * g0 + g1 * g1) + (g2 * g2 + g3 * g3);
                u32x2 w; w.x = cvtpk(g0 * nw.x, g1 * nw.y); w.y = cvtpk(g2 * nw.z, g3 * nw.w);
                *(u32x2*)(P_MIX + (size_t)row * DM + 2048 + h * 64 + 32 * pt + 8 * r4 + 4 * hi) = w; }
            ssq += __shfl_xor(ssq, 32);
            if (hi == 0) atomicAdd(P_ssq + SSQ_REP_OFF + row, ssq);
        }
        __syncthreads();
        {
            const int pt = F.wave & 1, nt = F.wave >> 1; const float eend = __expf(acs_end);
#pragma unroll
            for (int i = 0; i < 16; ++i) hacc[i] *= eend;
#pragma unroll
            for (int ks = 0; ks < 8; ++ks) { const int srow = 16 * ks + 8 * hi + (i16 >> 2), cofs = ((g4 & 1) * 16 + (i16 & 3) * 4) * 2;
                const LAS unsigned char* a = L + L_XW + srow * XSTR + 64 * pt + cofs; const LAS unsigned char* bp = L + L_BS + srow * BSTR + 64 * nt + cofs;
                hacc = MFMA32(cat4(vtr(a), vtr(a + 4 * XSTR)), cat4(vtr(bp), vtr(bp + 4 * BSTR)), hacc); }
#pragma unroll
            for (int r = 0; r < 16; ++r) *(LAS unsigned short*)(L + L_HS + (32 * pt + crow(r, hi)) * BSTR + (32 * nt + q) * 2) = (unsigned short)(cvtpk(hacc[r], 0.f) & 0xffffu);
        }
    }
    {   const int pt = F.wave & 1, nt = F.wave >> 1;
#pragma unroll
        for (int r = 0; r < 16; ++r) P_out[O_PSSM + ((size_t)(b * 32 + h) * 64 + 32 * pt + crow(r, hi)) * 128 + 32 * nt + q] = hacc[r]; }
}

__device__ __forceinline__ void ssd_sample_unit(const Frame& F, const Ptrs& P, int unit) {
    const int grp = unit & 7, b = unit >> 3;
    LAS float* XC = (LAS float*)(F.lds + RING_OFF); LAS float* BC = XC + 2048; LAS float* CC = BC + 1024; LAS float* DTVs = CC + 1024; LAS float* DAs = DTVs + 32; LAS float* ZC = DAs + 32;
    {   const int ci = F.tid; int ch, stride; LAS float* dst;
        if (ci < 256) { ch = grp * 256 + ci; dst = XC + ci; stride = 256; } else if (ci < 384) { ch = 2048 + grp * 128 + (ci - 256); dst = BC + (ci - 256); stride = 128; } else { ch = 3072 + grp * 128 + (ci - 384); dst = CC + (ci - 384); stride = 128; }
        float xp[11];
#pragma unroll
        for (int j = 0; j < 3; ++j) xp[j] = P_st_conv[((size_t)b * 3 + j) * 4096 + ch];
#pragma unroll
        for (int t = 0; t < 8; ++t) xp[3 + t] = bf2f(P_PROJ[(size_t)(MP + b * 8 + t) * LDP + C_X + ch]);
        const float w0 = P_conv_w[ch], w1 = P_conv_w[4096 + ch], w2 = P_conv_w[8192 + ch], w3 = P_conv_w[12288 + ch], bb = P_conv_b[ch];
#pragma unroll
        for (int t = 0; t < 8; ++t) dst[t * stride] = silu_f(bb + w0 * xp[t] + w1 * xp[t + 1] + w2 * xp[t + 2] + w3 * xp[t + 3]);
#pragma unroll
        for (int j = 0; j < 3; ++j) P_out[O_SCONV + ((size_t)b * 3 + j) * 4096 + ch] = xp[8 + j];
        if (ci < 256) {
#pragma unroll
            for (int t = 0; t < 8; ++t) ZC[t * 256 + ci] = bf2f(P_PROJ[(size_t)(MP + b * 8 + t) * LDP + C_Z + grp * 256 + ci]); }
    }
    if (F.tid < 32) { const int hh = F.tid >> 3, t = F.tid & 7, h = grp * 4 + hh;
        const float dv = softplus_f(bf2f(P_PROJ[(size_t)(MP + b * 8 + t) * LDP + C_DT + h]) + P_dt_bias[h]); DTVs[F.tid] = dv; DAs[F.tid] = __expf(-dv * __expf(P_A_log[h])); }
    __syncthreads();
    const int hh = F.wave >> 1, half = F.wave & 1, h = grp * 4 + hh, n4 = F.lane & 31, prow = F.lane >> 5;
    const size_t sofs = ((size_t)(b * 32 + h) * 64 + 32 * half + prow) * 128 + 4 * n4;
    f32x4 hreg[16];
#pragma unroll
    for (int i = 0; i < 16; ++i) hreg[i] = *(const f32x4*)(P_st_ssm + sofs + (size_t)(2 * i) * 128);
    const float Dh = P_Dv[h]; const bool valid = n4 < 16; const int p = 32 * half + 2 * (n4 & 15) + prow; const float nw = P_ssd_nw[h * 64 + p];
#pragma unroll 1
    for (int t = 0; t < 8; ++t) {
        const float da = DAs[hh * 8 + t], dv = DTVs[hh * 8 + t]; const f32x4 B4 = *(const LAS f32x4*)(BC + t * 128 + 4 * n4), C4 = *(const LAS f32x4*)(CC + t * 128 + 4 * n4);
        float yt = 0.f;
#pragma unroll
        for (int i = 0; i < 16; ++i) { const float xv = XC[t * 256 + hh * 64 + 32 * half + 2 * i + prow] * dv; hreg[i] = hreg[i] * da + xv * B4;
            float part = (hreg[i].x * C4.x + hreg[i].y * C4.y) + (hreg[i].z * C4.z + hreg[i].w * C4.w);
            part += __shfl_xor(part, 1); part += __shfl_xor(part, 2); part += __shfl_xor(part, 4); part += __shfl_xor(part, 8); part += __shfl_xor(part, 16);
            if (n4 == i) yt = part; }
        const int row = MP + b * 8 + t;
        const float x = XC[t * 256 + hh * 64 + p], z = ZC[t * 256 + hh * 64 + p]; const float yg = (yt + Dh * x) * silu_f(z);
        const float ss = wave_sum(valid ? yg * yg : 0.f);
        if (F.lane == 0) atomicAdd(P_ssq + SSQ_REP_OFF + row, ss);
        if (valid) P_MIX[(size_t)row * DM + 2048 + h * 64 + p] = (bf16)(cvtpk(yg * nw, 0.f) & 0xffffu);
    }
#pragma unroll
    for (int i = 0; i < 16; ++i) *(f32x4*)(P_out + O_SSSM + sofs + (size_t)(2 * i) * 128) = hreg[i];
}

__device__ __forceinline__ void p2_mixer(const Frame& F, const Ptrs& P, volatile LAS unsigned* slot, int rep) {
    {
        LAS float* TB = (LAS float*)(F.lds + TB_OFF);
        for (int i = F.tid; i < 16 * 128; i += 512) { const int hd = i >> 7, dist = i & 127; TB[i] = P_rel_bias[t5_bucket(dist) * 16 + hd] * LOG2E; }
    }
#ifndef MIX_MASK
#define MIX_MASK 15
#endif
    if (MIX_MASK & 1) for (;;) { const int u = wq_next(P_ctl + CW_Q + (0 + 4 * rep) * 64, slot, F.tid); if (u >= 128) break; ssd_prompt_unit(F, P, u); }
    if (MIX_MASK & 2) for (;;) { const int u = wq_next(P_ctl + CW_Q + (1 + 4 * rep) * 64, slot, F.tid); if (u >= 512) break; attn_prompt_unit(F, P, u); }
    if (MIX_MASK & 4) for (;;) { const int u = wq_next(P_ctl + CW_Q + (2 + 4 * rep) * 64, slot, F.tid); if (u >= 512) break; attn_sample_unit(F, P, u); }
    if (MIX_MASK & 8) { Frame F2 = F; asm volatile("" : "+v"(F2.tid), "+v"(F2.lane));
        for (;;) { const int u = wq_next(P_ctl + CW_Q + (3 + 4 * rep) * 64, slot, F2.tid); if (u >= 1024) break; ssd_sample_unit(F2, P, u); } }
}

__device__ __forceinline__ void p3_ssd_norm(const Frame& F, const Ptrs& P) {
    const int gw = F.bid * NWAVES + F.wave, NGW = F.G * NWAVES;
    for (int m = gw; m < M; m += NGW) { const float rstd = 1.0f / sqrtf(P_ssq[m] * (1.0f / 2048.0f) + EPS); u32x4* mp = (u32x4*)(P_MIX + (size_t)m * DM + 2048) + F.lane;
#pragma unroll
        for (int j = 0; j < 4; ++j) { float f[8]; unpack8(mp[64 * j], f);
#pragma unroll
            for (int i = 0; i < 8; ++i) f[i] *= rstd;
            mp[64 * j] = pack8(f); } }
}
__device__ __forceinline__ size_t slab_off(int rs, int c, int kp) { return ((size_t)(((rs >> 8) * 16 + (c >> 8)) * 4 + kp)) * 65536 + (size_t)(rs & 255) * 256 + (c & 255); }
__device__ __forceinline__ void p5_ffn_norm(const Frame& F, const Ptrs& P) {
    const int gw = F.bid * NWAVES + F.wave, NGW = F.G * NWAVES;
    for (int m = gw; m < M; m += NGW) {
        if (m >= MP) { const int rs = m - MP; const float* slab = (const float*)(P_ws + WS_SLAB); f32x4 v[16];
#pragma unroll
            for (int j = 0; j < 16; ++j) { const int c = 4 * (F.lane + 64 * j); v[j] = *(const f32x4*)(P_x_sample + (size_t)rs * DM + c);
#pragma unroll
                for (int kp = 0; kp < 4; ++kp) v[j] += *(const f32x4*)(slab + slab_off(rs, c, kp));
                *(f32x4*)(P_out + (size_t)m * DM + c) = v[j]; }
            rms_regs_to_bf16(v, P_ffn_nw, P_XN + (size_t)m * DM, F.lane);
        } else rms_row_to_bf16(P_out + (size_t)m * DM, P_ffn_nw, P_XN + (size_t)m * DM, F.lane);
    }
}
__device__ __forceinline__ void p9_final_reduce(const Frame& F, const Ptrs& P) {
    const int gw = F.bid * NWAVES + F.wave, NGW = F.G * NWAVES; const float* slab = (const float*)(P_ws + WS_SLAB);
    for (int rs = gw; rs < MS; rs += NGW) {
#pragma unroll 4
        for (int j = 0; j < 16; ++j) { const int c = 4 * (F.lane + 64 * j); float* o = P_out + (size_t)(MP + rs) * DM + c; f32x4 v = *(const f32x4*)o;
#pragma unroll
            for (int kp = 0; kp < 4; ++kp) v += *(const f32x4*)(slab + slab_off(rs, c, kp));
            *(f32x4*)o = v; }
    }
}
__device__ __forceinline__ void p7_conv_act(const Frame& F, const Ptrs& P) {
    constexpr int NCC = DFF / 8; const int ntask = (M / 8) * NCC;
    for (int task = F.bid * 512 + F.tid; task < ntask; task += F.G * 512) {
        const int cc = task % NCC, rb = task / NCC, j0 = cc * 8, gcol = 256 * (j0 >> 7) + (j0 & 127), r0 = rb * 8;
        float w0[8], w1[8], w2[8], bb[8], pm2[8], pm1[8];
#pragma unroll
        for (int i = 0; i < 8; ++i) { w0[i] = P_fconv_w[j0 + i]; w1[i] = P_fconv_w[DFF + j0 + i]; w2[i] = P_fconv_w[2 * DFF + j0 + i]; bb[i] = P_fconv_b[j0 + i]; pm2[i] = 0.f; pm1[i] = 0.f; }
        if (r0 < MP) { if ((r0 & (SEQ - 1)) != 0) { unpack8(*(const u32x4*)(P_GU + (size_t)(r0 - 2) * NGU + gcol), pm2); unpack8(*(const u32x4*)(P_GU + (size_t)(r0 - 1) * NGU + gcol), pm1); } }
        else { const int bs = (r0 - MP) >> 3;
#pragma unroll
            for (int i = 0; i < 8; ++i) { pm2[i] = P_st_ffn[((size_t)bs * 2 + 0) * DFF + j0 + i]; pm1[i] = P_st_ffn[((size_t)bs * 2 + 1) * DFF + j0 + i]; } }
#pragma unroll
        for (int t = 0; t < 8; ++t) { const int r = r0 + t; float g[8], u[8], a[8];
            unpack8(*(const u32x4*)(P_GU + (size_t)r * NGU + gcol), g); unpack8(*(const u32x4*)(P_GU + (size_t)r * NGU + gcol + 128), u);
#pragma unroll
            for (int i = 0; i < 8; ++i) a[i] = silu_f(bb[i] + w0[i] * pm2[i] + w1[i] * pm1[i] + w2[i] * g[i]) * u[i];
            *(u32x4*)(P_ACT + (size_t)r * DFF + j0) = pack8(a);
            if (r < MP) { const int pos = r & (SEQ - 1); if (pos >= SEQ - 2) { float* o = P_out + O_PFFN + ((size_t)(r >> 11) * 2 + (pos - (SEQ - 2))) * DFF + j0;
                *(f32x4*)o = (f32x4){g[0], g[1], g[2], g[3]}; *(f32x4*)(o + 4) = (f32x4){g[4], g[5], g[6], g[7]}; } }
            else if (t >= 6) { float* o = P_out + O_SFFN + ((size_t)((r0 - MP) >> 3) * 2 + (t - 6)) * DFF + j0; *(f32x4*)o = (f32x4){g[0], g[1], g[2], g[3]}; *(f32x4*)(o + 4) = (f32x4){g[4], g[5], g[6], g[7]}; }
#pragma unroll
            for (int i = 0; i < 8; ++i) { pm2[i] = pm1[i]; pm1[i] = g[i]; } }
    }
}

__global__ void __launch_bounds__(NWAVES * 64, 2) hymba_fwd(Args args) {
    extern __shared__ __attribute__((aligned(16))) unsigned char lds_raw[];
    Frame F; F.lds = (LAS unsigned char*)lds_raw; F.tid = threadIdx.x; F.lane = F.tid & 63; F.wave = __builtin_amdgcn_readfirstlane(F.tid >> 6); F.G = KARG->grid; F.bid = blockIdx.x;
    volatile LAS unsigned* MISC = (volatile LAS unsigned*)(F.lds + MISC_OFF);
    Ptrs P;
    for (int u = F.tid; u < (LDS_BYTES - LDSCTL_OFF) / 4; u += NWAVES * 64) ((LAS unsigned*)(F.lds + LDSCTL_OFF))[u] = 0u;
    __syncthreads();
    if (N_LAUNCHES == 1) (void)xcd_barrier_post((unsigned*)(P_ctl + CW_BAR), MISC + 8);
    const int lo = KARG->ph_lo, hi = KARG->ph_hi;
#ifndef PHASE_MASK
#define PHASE_MASK 0x3ff
#endif
#define IN(k) ((((PHASE_MASK) >> (k)) & 1) && lo <= (k) && (k) < hi)
#define SEAM(k) do { if (IN(k) && IN((k) + 1)) { XcdBarrier b_; b_.bar = (unsigned*)(P_ctl + CW_BAR); b_.x = xb_xcc_id(); b_.st = MISC + 8; xcd_barrier(b_); } } while (0)

    if (IN(0)) { for (int rep = 0; rep < NREP_P0; ++rep) p0_prologue(F, P); } SEAM(0);
    if (IN(1)) {
        pg8::Gemm g{P_XN, P_W1, M, LDP, DM}; pg8::StaticOrder S; S.init(M, LDP, F.G, F.bid, DM);
        pg8::EpiStoreBf16 E{P_PROJ, LDP};
        pg8::gemm_phase<pg8::EpiStoreBf16, pg8::StaticOrder, PG8_ALIGN, PG8_SP2>(F.lds + RING_OFF, g, S, E);
        tail_filler<3>(F, (M / 256) * (LDP / 256));
    } SEAM(1);
    if (IN(2)) { for (int rep = NREP_MIX - 1; rep >= 0; --rep) { if (F.tid == 0) MISC[5] = (unsigned)(rep * M); __syncthreads(); p2_mixer(F, P, MISC + 4, rep); } } SEAM(2);
    if (IN(3)) { p3_ssd_norm(F, P); } SEAM(3);
    if (IN(4)) {
        pg8::Gemm g{P_MIX, P_W2, M, DM, DM};
        { pg8::StaticOrder S; S.init(MP, DM, F.G, F.bid, DM); pg8::EpiResF32 E{P_x_prompt, P_x_sample, MP, P_out, DM};
          pg8::gemm_phase<pg8::EpiResF32, pg8::StaticOrder, PG8_ALIGN, PG8_SP2>(F.lds + RING_OFF, g, S, E); }
        { pg8::PieceOrder S{F.G, F.bid, MP / 256, DM / 256, 4 * (MS / 256) * (DM / 256), 16, 16}; pg8::EpiSlab E{(float*)(P_ws + WS_SLAB)};
          pg8::gemm_phase<pg8::EpiSlab, pg8::PieceOrder, PG8_ALIGN, PG8_SP2>(F.lds + RING_OFF, g, S, E); }
    } SEAM(4);
    if (IN(5)) { p5_ffn_norm(F, P); } SEAM(5);
    if (IN(6)) {
        pg8::Gemm g{P_XN, P_W3, M, NGU, DM}; pg8::StaticOrder S; S.init(M, NGU, F.G, F.bid, DM);
        pg8::EpiStoreBf16 E{P_GU, NGU};
        pg8::gemm_phase<pg8::EpiStoreBf16, pg8::StaticOrder, PG8_ALIGN, PG8_SP2>(F.lds + RING_OFF, g, S, E);
        tail_filler<4>(F, (M / 256) * (NGU / 256));
    } SEAM(6);
    if (IN(7)) { p7_conv_act(F, P); } SEAM(7);
    if (IN(8)) {
        pg8::Gemm g{P_ACT, P_W4, M, DM, DFF};
        { pg8::StaticOrder S; S.init(MP, DM, F.G, F.bid, DFF); pg8::EpiResF32 E{P_out, P_out, M, P_out, DM};
          pg8::gemm_phase<pg8::EpiResF32, pg8::StaticOrder, PG8_ALIGN, PG8_SP2>(F.lds + RING_OFF, g, S, E); }
        { pg8::PieceOrder S{F.G, F.bid, MP / 256, DM / 256, 4 * (MS / 256) * (DM / 256), 44, 42}; pg8::EpiSlab E{(float*)(P_ws + WS_SLAB)};
          pg8::gemm_phase<pg8::EpiSlab, pg8::PieceOrder, PG8_ALIGN, PG8_SP2>(F.lds + RING_OFF, g, S, E); }
    } SEAM(8);
    if (IN(9)) { p9_final_reduce(F, P); }
#undef IN
#undef SEAM
}

extern "C" void kernel_launch(void* const* d_in, const int* in_sizes, int n_in, void* d_out, int out_size, void* d_ws, size_t ws_size, hipStream_t stream) {
    static int grid = 0;
    if (grid == 0) {
        if (n_in != 26 || (size_t)out_size != O_END || ws_size < WS_END) { fprintf(stderr, "kernel_launch: unexpected shapes: n_in %d out %d ws %zu (need %zu); nothing launched\n", n_in, out_size, ws_size, (size_t)WS_END); grid = -1; return; }
        int dev = 0, cus = 0, per_cu = 0;
        if (hipGetDevice(&dev) != hipSuccess || hipDeviceGetAttribute(&cus, hipDeviceAttributeMultiprocessorCount, dev) != hipSuccess) { grid = -1; return; }
        if (hipFuncSetAttribute((const void*)hymba_fwd, hipFuncAttributeMaxDynamicSharedMemorySize, LDS_BYTES) != hipSuccess) { fprintf(stderr, "kernel_launch: hipFuncSetAttribute failed\n"); grid = -1; return; }
        if (hipOccupancyMaxActiveBlocksPerMultiprocessor(&per_cu, (const void*)hymba_fwd, NWAVES * 64, LDS_BYTES) != hipSuccess || per_cu < 1) { fprintf(stderr, "kernel_launch: occupancy query reports %d blocks per CU\n", per_cu); }
        (void)hipGetLastError();
        grid = cus;
    }
    if (grid < 0) return;
    if (hipMemsetAsync((char*)d_ws + WS_CTL, 0, CTL_ZERO_BYTES, stream) != hipSuccess) return;
    Args a{};
    for (int i = 0; i < 26; ++i) a.in[i] = (const float*)d_in[i];
    a.out = (float*)d_out; a.ws = (unsigned char*)d_ws; a.grid = grid; a.pad = 0;
    if (N_LAUNCHES == 1) { a.ph_lo = 0; a.ph_hi = N_PHASES; hipLaunchKernelGGL(hymba_fwd, dim3(grid), dim3(NWAVES * 64), LDS_BYTES, stream, a); }
    else { for (int li = 0; li < N_PHASES; ++li) { a.ph_lo = li; a.ph_hi = li + 1; hipLaunchKernelGGL(hymba_fwd, dim3(grid), dim3(NWAVES * 64), LDS_BYTES, stream, a); } }
}
```

```cpp
#include <hip/hip_runtime.h>
#include <cstdio>
#include <cstdint>
namespace pg8 {
#define PG8_LAS __attribute__((address_space(3)))
typedef unsigned short bf16_t;
typedef short bf16x8 __attribute__((ext_vector_type(8)));
typedef float f32x4 __attribute__((ext_vector_type(4)));
typedef unsigned u32x4 __attribute__((ext_vector_type(4)));
constexpr int BM = 256, BK = 64, HALF = 128, HTB = HALF * BK * 2  , STAGE_BYTES = 8 * HTB, NXCD = 8, WGM = 8;

__host__ __device__ __forceinline__ int lds_byte(int r, int c) { const int st = (r >> 4) * 2 + (c >> 5), rr = r & 15, cc = c & 31, ob = rr * 64 + cc * 2; return st * 1024 + (ob ^ (((ob >> 9) & 1) << 5)); }
__host__ __device__ __forceinline__ void stage_rc(int b, int& R, int& C) { const int st = b / 1024, sb = b % 1024, swz = sb ^ (((sb >> 9) & 1) << 5); R = (st >> 1) * 16 + swz / 64; C = (st & 1) * 32 + (swz % 64) / 2; }
__host__ __device__ __forceinline__ int perm32(int rho) { const int n = rho >> 4, i = rho & 15; return 8 * (i >> 2) + 4 * n + (i & 3); }

struct Unit { int pm, pn, kt0, nt, aux; };
struct Gemm { const bf16_t* A; const bf16_t* Bt; int M, N, K; };

struct StaticOrder {
    int nM, nN, nwg, G, c, ntf, pm0;
    __host__ __device__ void init(int M, int N, int G_, int c_, int K_ = 0, int pm0_ = 0) { nM = M / BM; nN = N / BM; nwg = nM * nN; G = G_; c = c_; ntf = K_ / BK; pm0 = pm0_; }
    __host__ __device__ bool next(int i, Unit& u) const {
        const long L = (long)i * G + c; if (L >= nwg) return false;
        int wgid = (int)L; { const int q = nwg / NXCD, r = nwg % NXCD, xcd = wgid % NXCD, off = wgid / NXCD; wgid = (xcd < r ? xcd * (q + 1) : r * (q + 1) + (xcd - r) * q) + off; }
        const int nig = WGM * nN, gid = wgid / nig, fm = gid * WGM, gsz = (nM - fm) < WGM ? (nM - fm) : WGM;
        u.pm = pm0 + fm + ((wgid % nig) % gsz); u.pn = (wgid % nig) / gsz; u.kt0 = 0; u.nt = ntf; u.aux = 0; return true;
    }
    __device__ __forceinline__ void a_ready(const Unit&) const {}
    __device__ __forceinline__ void done(const Unit&) const {}
};

__device__ __forceinline__ unsigned cvt_pk_bf16(float lo, float hi) { unsigned r; asm volatile("v_cvt_pk_bf16_f32 %0, %1, %2" : "=v"(r) : "v"(lo), "v"(hi)); return r; }
typedef float f32x2 __attribute__((ext_vector_type(2)));

struct EpiStoreBf16 {
    static constexpr bool PERM = true, AFTER_DRAIN = false, MIDK = false;
    bf16_t* O; int ldc;
    __device__ __forceinline__ void operator()(const f32x4 (&acc)[2][2][4][2], const Unit& u, int wr, int wc, int fr, int fq) const {
        const int row0 = u.pm * BM + wr * 64 + fr; const int col0 = u.pn * BM + wc * 32 + 8 * fq;
#pragma unroll
        for (int ai = 0; ai < 2; ++ai)
#pragma unroll
            for (int m = 0; m < 4; ++m) { bf16_t* rowp = O + (size_t)(row0 + ai * HALF + m * 16) * ldc + col0;
#pragma unroll
                for (int bj = 0; bj < 2; ++bj) { const f32x4 v0 = acc[ai][bj][m][0], v1 = acc[ai][bj][m][1];
                    u32x4 w; w.x = cvt_pk_bf16(v0[0], v0[1]); w.y = cvt_pk_bf16(v0[2], v0[3]); w.z = cvt_pk_bf16(v1[0], v1[1]); w.w = cvt_pk_bf16(v1[2], v1[3]);
                    *(u32x4*)(rowp + bj * HALF) = w; } }
    }
};
struct EpiResF32 {
    static constexpr bool PERM = false, AFTER_DRAIN = false, MIDK = false;
    const float* base0; const float* base1; int split_row; float* out; int ldc;
    __device__ __forceinline__ void operator()(const f32x4 (&acc)[2][2][4][2], const Unit& u, int wr, int wc, int fr, int fq) const {
        const int row0 = u.pm * BM + wr * 64 + fr; const int col0 = u.pn * BM + wc * 32 + 4 * fq;
        const float* base = (u.pm * BM >= split_row) ? (base1 - (size_t)split_row * ldc) : base0;
#pragma unroll
        for (int ai = 0; ai < 2; ++ai)
#pragma unroll
            for (int m = 0; m < 4; ++m) { const size_t off = (size_t)(row0 + ai * HALF + m * 16) * ldc + col0;
#pragma unroll
                for (int bj = 0; bj < 2; ++bj)
#pragma unroll
                    for (int n = 0; n < 2; ++n) { const f32x4 b = *(const f32x4*)(base + off + bj * HALF + n * 16); *(f32x4*)(out + off + bj * HALF + n * 16) = b + acc[ai][bj][m][n]; }
                if (m & 1) asm volatile("" ::: "memory"); }
    }
};

struct EpiSlab {
    static constexpr bool PERM = false, AFTER_DRAIN = false, MIDK = false;
    float* slab; const float* ssq_in; int scale_kt;
    __device__ __forceinline__ void operator()(const f32x4 (&acc)[2][2][4][2], const Unit& u, int wr, int wc, int fr, int fq) const {
        float* sp = slab + (size_t)u.aux * 65536 + (wr * 64 + fr) * 256 + wc * 32 + 4 * fq;
        const bool sc = ssq_in != nullptr && u.kt0 < scale_kt;
#pragma unroll
        for (int ai = 0; ai < 2; ++ai)
#pragma unroll
            for (int m = 0; m < 4; ++m) { float r = 1.0f; if (sc) r = 1.0f / sqrtf(ssq_in[u.pm * BM + ai * HALF + wr * 64 + m * 16 + fr] * (1.0f / 2048.0f) + 1e-6f);
#pragma unroll
                for (int bj = 0; bj < 2; ++bj)
#pragma unroll
                    for (int n = 0; n < 2; ++n) *(f32x4*)(sp + (ai * HALF + m * 16) * 256 + bj * HALF + n * 16) = acc[ai][bj][m][n] * r; }
    }
};
struct PieceOrder {
    int G, c, pm0, nN, npieces, ntA, ntB;
    __device__ __forceinline__ bool next(int i, Unit& u) const {
        const int L = i * G + c; if (L >= npieces) return false;
        int kp = L & 3, tile = L >> 2;
        if (G == 256 && npieces == 256) { const int x = c & 7; kp = x & 3; tile = 32 * (x >> 2) + (c >> 3); }
        u.pn = tile % nN; u.pm = pm0 + tile / nN; u.aux = 4 * tile + kp;
        if (kp < 2) { u.nt = ntA; u.kt0 = kp * ntA; } else { u.nt = ntB; u.kt0 = 2 * ntA + (kp - 2) * ntB; }
        return true;
    }
    __device__ __forceinline__ void a_ready(const Unit&) const {}
    __device__ __forceinline__ void done(const Unit&) const {}
};

struct EpiResBf16Ssq {
    static constexpr bool PERM = true, AFTER_DRAIN = false, MIDK = true;
    const float* base; bf16_t* O; float* ssq; int ldc; const float* ssq_in;
    __device__ __forceinline__ void midk(f32x4 (&acc)[2][2][4][2], const Unit& u, int wr, int fr) const {
#pragma unroll
        for (int ai = 0; ai < 2; ++ai)
#pragma unroll
            for (int m = 0; m < 4; ++m) { const float r = 1.0f / sqrtf(ssq_in[u.pm * BM + ai * HALF + wr * 64 + m * 16 + fr] * (1.0f / 2048.0f) + 1e-6f);
#pragma unroll
                for (int bj = 0; bj < 2; ++bj)
#pragma unroll
                    for (int n = 0; n < 2; ++n) acc[ai][bj][m][n] *= r; }
    }
    __device__ __forceinline__ void operator()(const f32x4 (&acc)[2][2][4][2], const Unit& u, int wr, int wc, int fr, int fq) const {
        const int row0 = u.pm * BM + wr * 64 + fr; const int col0 = u.pn * BM + wc * 32 + 8 * fq;
#pragma unroll
        for (int ai = 0; ai < 2; ++ai)
#pragma unroll
            for (int m = 0; m < 4; ++m) { const int row = row0 + ai * HALF + m * 16; const size_t off = (size_t)row * ldc + col0; float ss = 0.f;
#pragma unroll
                for (int bj = 0; bj < 2; ++bj) { const f32x4 v0 = *(const f32x4*)(base + off + bj * HALF) + acc[ai][bj][m][0], v1 = *(const f32x4*)(base + off + bj * HALF + 4) + acc[ai][bj][m][1];
                    ss += (v0[0] * v0[0] + v0[1] * v0[1]) + (v0[2] * v0[2] + v0[3] * v0[3]) + (v1[0] * v1[0] + v1[1] * v1[1]) + (v1[2] * v1[2] + v1[3] * v1[3]);
                    u32x4 w; w.x = cvt_pk_bf16(v0[0], v0[1]); w.y = cvt_pk_bf16(v0[2], v0[3]); w.z = cvt_pk_bf16(v1[0], v1[1]); w.w = cvt_pk_bf16(v1[2], v1[3]);
                    *(u32x4*)(O + off + bj * HALF) = w; }
                ss += __shfl_xor(ss, 16); ss += __shfl_xor(ss, 32);
                if (fq == 0) atomicAdd(ssq + row, ss);
                if (m & 1) asm volatile("" ::: "memory"); }
    }
};
struct EpiResFromBf16 {
    static constexpr bool PERM = true, AFTER_DRAIN = false, MIDK = false;
    const bf16_t* X; float* out; int ldc;
    __device__ __forceinline__ void operator()(const f32x4 (&acc)[2][2][4][2], const Unit& u, int wr, int wc, int fr, int fq) const {
        const int row0 = u.pm * BM + wr * 64 + fr; const int col0 = u.pn * BM + wc * 32 + 8 * fq;
#pragma unroll
        for (int ai = 0; ai < 2; ++ai)
#pragma unroll
            for (int m = 0; m < 4; ++m) { const size_t off = (size_t)(row0 + ai * HALF + m * 16) * ldc + col0;
#pragma unroll
                for (int bj = 0; bj < 2; ++bj) { const u32x4 w = *(const u32x4*)(X + off + bj * HALF);
                    f32x4 b0, b1; b0[0] = __uint_as_float(w.x << 16); b0[1] = __uint_as_float(w.x & 0xffff0000u); b0[2] = __uint_as_float(w.y << 16); b0[3] = __uint_as_float(w.y & 0xffff0000u);
                    b1[0] = __uint_as_float(w.z << 16); b1[1] = __uint_as_float(w.z & 0xffff0000u); b1[2] = __uint_as_float(w.w << 16); b1[3] = __uint_as_float(w.w & 0xffff0000u);
                    *(f32x4*)(out + off + bj * HALF) = b0 + acc[ai][bj][m][0]; *(f32x4*)(out + off + bj * HALF + 4) = b1 + acc[ai][bj][m][1]; }
                if (m & 1) asm volatile("" ::: "memory"); }
    }
};

struct ChainOrder {
    StaticOrder S0; int ntA, ntB;
    __device__ __forceinline__ bool next(int i, Unit& u) const { if (!S0.next(i >> 1, u)) return false; if (i & 1) { u.kt0 = ntA; u.nt = ntB; u.aux = 0; } else { u.kt0 = 0; u.nt = ntA; u.aux = 1; } return true; }
    __device__ __forceinline__ void a_ready(const Unit&) const {}
    __device__ __forceinline__ void done(const Unit&) const {}
};

struct HalfMOrder {
    int G, c, ntf;
    __device__ __forceinline__ bool next(int i, Unit& u) const {
        if (G != 256) { const int L = i * G + c; if (L >= 512) return false; u.pm = L >> 4; u.pn = L & 15; u.kt0 = 0; u.nt = ntf; u.aux = 0; return true; }
        if (i >= 2) return false;
        const int xcd = c & 7, r = c >> 3; u.pm = 16 * i + (xcd >> 1) * 4 + (r & 3); u.pn = (xcd & 1) * 8 + (r >> 2); u.kt0 = 0; u.nt = ntf; u.aux = 0; return true;
    }
    __device__ __forceinline__ void a_ready(const Unit&) const {}
    __device__ __forceinline__ void done(const Unit&) const {}
};

struct Gemm3BlockOrder {
    int G, c, ntf;
    __device__ __forceinline__ bool next(int i, Unit& u) const {
        u.kt0 = 0; u.nt = ntf; u.aux = 0;
        if (G != 256) { const int L = i * G + c; if (L >= 3072) return false; if (L < 2752) { u.pm = L / 86; u.pn = L % 86; } else { u.pm = 32 + (L - 2752) / 80; u.pn = (L - 2752) % 80; } return true; }
        if (i >= 12) return false;
        const int x = c & 7, r = c >> 3, k = i * 8 + x;
        if (k < 84) { const int g = k / 21, jb = k % 21; u.pm = 8 * g + (r & 7); u.pn = 4 * jb + (r >> 3); }
        else if (k < 94) { const int jb = k - 84; u.pm = 32 + (r & 3); u.pn = 8 * jb + (r >> 2); }
        else { const int g = 2 * (k - 94) + (r >> 4); u.pm = 8 * g + (r & 7); u.pn = 84 + ((r >> 3) & 1); }
        return true;
    }
    __device__ __forceinline__ void a_ready(const Unit&) const {}
    __device__ __forceinline__ void done(const Unit&) const {}
};
struct TailPieceOrder {
    int G, c, npieces;
    __device__ __forceinline__ bool next(int i, Unit& u) const { const int L = i * G + c; if (L >= npieces) return false; const int t = L >> 3; u.pm = 32 + (t & 3); u.pn = 80 + (t >> 2); u.kt0 = 8 * (L & 7); u.nt = 8; u.aux = L; return true; }
    __device__ __forceinline__ void a_ready(const Unit&) const {}
    __device__ __forceinline__ void done(const Unit&) const {}
};
struct Gemm1BlockOrder {
    int G, c, ntf;
    __device__ __forceinline__ bool next(int i, Unit& u) const {
        u.kt0 = 0; u.nt = ntf; u.aux = 0;
        if (G != 256) { const int L = i * G + c; if (L >= 1332) return false; u.pm = L / 37; u.pn = L % 37; return true; }
        if (i < 5) { const int x = c & 7, r = c >> 3, k = i * 8 + x;
            if (k < 36) { const int g = k / 9, jb = k % 9; u.pm = 8 * g + (r & 7); u.pn = 4 * jb + (r >> 3); } else { const int jb = k - 36; u.pm = 32 + (r & 3); u.pn = 8 * jb + (r >> 2); }
            return true; }
        if (i > 5 || c >= 52) return false;
        if (c < 32) { u.pm = c; u.pn = 36; } else { const int s = c - 32; u.pm = 32 + (s & 3); u.pn = 32 + (s >> 2); }
        return true;
    }
    __device__ __forceinline__ void a_ready(const Unit&) const {}
    __device__ __forceinline__ void done(const Unit&) const {}
};
struct EpiSlabPerm {
    static constexpr bool PERM = true, AFTER_DRAIN = false, MIDK = false;
    float* slab;
    __device__ __forceinline__ void operator()(const f32x4 (&acc)[2][2][4][2], const Unit& u, int wr, int wc, int fr, int fq) const {
        float* sp = slab + (size_t)u.aux * 65536 + (wr * 64 + fr) * 256 + wc * 32 + 8 * fq;
#pragma unroll
        for (int ai = 0; ai < 2; ++ai)
#pragma unroll
            for (int m = 0; m < 4; ++m)
#pragma unroll
                for (int bj = 0; bj < 2; ++bj)
#pragma unroll
                    for (int n = 0; n < 2; ++n) *(f32x4*)(sp + (ai * HALF + m * 16) * 256 + bj * HALF + 4 * n) = acc[ai][bj][m][n];
    }
};

template <class Epi, class Sched, bool ALIGN_EPI = false, bool SP2 = false, bool A_TILED = false, bool B_TILED = false, bool A_NT = false>
__device__ __forceinline__ void gemm_phase(PG8_LAS unsigned char* lds, const Gemm g, const Sched& S, const Epi& E) {
    const int tid = threadIdx.x, wid = __builtin_amdgcn_readfirstlane(tid >> 6), lane = tid & 63, wr = wid >> 2, wc = wid & 3, fr = lane & 15, fq = lane >> 4;
    const int K = g.K; int nt;
    unsigned voffA[2], voffB[2];
#pragma unroll
    for (int i = 0; i < 2; ++i) { int R, C; stage_rc(tid * 16 + i * 8192, R, C); const int Rb = Epi::PERM ? ((R & ~31) + perm32(R & 31)) : R;
        voffA[i] = A_TILED ? (unsigned)(R * BK + C) * 2u : (unsigned)(R * K + C) * 2u; voffB[i] = B_TILED ? (unsigned)(Rb * BK + C) * 2u : (unsigned)(Rb * K + C) * 2u; }
    const size_t kstep = (size_t)(BK * 2);
    const size_t hstep = (size_t)HALF * K * 2;
    const size_t tstep = 2 * hstep;
    const size_t kstepA = A_TILED ? (size_t)(BM * BK * 2) : kstep, hstepA = A_TILED ? (size_t)(HALF * BK * 2) : hstep, kstepB = B_TILED ? (size_t)(BM * BK * 2) : kstep, hstepB = B_TILED ? (size_t)(HALF * BK * 2) : hstep;
    const unsigned ldsw = (unsigned)wid * 1024u;
    const int aoff = lds_byte(wr * 64 + fr, fq * 8), boff = lds_byte(wc * 32 + fr, fq * 8);
#define PG8_SA(b, h) (((b) * 2 + (h)) * HTB)
#define PG8_SB(b, h) ((4 + (b) * 2 + (h)) * HTB)
#define PG8_STAGE(bufoff, gbase, voff) do { _Pragma("unroll") for (int _i = 0; _i < 2; ++_i) \
        __builtin_amdgcn_global_load_lds((const unsigned*)((const char*)(gbase) + (voff)[_i]), (PG8_LAS unsigned*)(lds + (bufoff) + ldsw + _i * 8192), 16, 0, 0); } while (0)
#define PG8_STAGE_A(bufoff, gbase, voff) do { _Pragma("unroll") for (int _i = 0; _i < 2; ++_i) \
        __builtin_amdgcn_global_load_lds((const unsigned*)((const char*)(gbase) + (voff)[_i]), (PG8_LAS unsigned*)(lds + (bufoff) + ldsw + _i * 8192), 16, 0, A_NT ? 2 : 0); } while (0)
#define PG8_LDA(dst, b, h) do { _Pragma("unroll") for (int m = 0; m < 4; ++m) _Pragma("unroll") for (int k = 0; k < 2; ++k) dst[m][k] = *(const PG8_LAS bf16x8*)(lds + PG8_SA(b, h) + aoff + m * 2048 + k * 1024); } while (0)
#define PG8_LDB(dst, b, h) do { _Pragma("unroll") for (int n = 0; n < 2; ++n) _Pragma("unroll") for (int k = 0; k < 2; ++k) dst[n][k] = *(const PG8_LAS bf16x8*)(lds + PG8_SB(b, h) + boff + n * 2048 + k * 1024); } while (0)
#define PG8_MMA(ai, bj, At, Bt) do { __builtin_amdgcn_s_setprio(1); _Pragma("unroll") for (int m = 0; m < 4; ++m) _Pragma("unroll") for (int n = 0; n < 2; ++n) _Pragma("unroll") for (int k = 0; k < 2; ++k) \
        acc[ai][bj][m][n] = __builtin_amdgcn_mfma_f32_16x16x32_bf16(Bt[n][k], At[m][k], acc[ai][bj][m][n], 0, 0, 0); __builtin_amdgcn_s_setprio(0); } while (0)
#define PG8_WAIT_V(n) asm volatile("s_waitcnt vmcnt(" #n ")" ::: "memory")
#define PG8_WAIT_L(n) asm volatile("s_waitcnt lgkmcnt(" #n ")" ::: "memory")
#define PG8_BAR __builtin_amdgcn_s_barrier()
#define PG8_SCHED __builtin_amdgcn_sched_barrier(0)
    Unit cur, nxt; int ui = 0;
    if (!S.next(0, cur)) return;
    nt = cur.nt;
    f32x4 acc[2][2][4][2];
#pragma unroll
    for (int a = 0; a < 2; ++a)
#pragma unroll
        for (int b = 0; b < 2; ++b)
#pragma unroll
            for (int m = 0; m < 4; ++m)
#pragma unroll
                for (int n = 0; n < 2; ++n) acc[a][b][m][n] = (f32x4){0.f, 0.f, 0.f, 0.f};
    bf16x8 At[4][2], B0[2][2], B1[2][2];
    const char* cA = (const char*)g.A + (size_t)cur.pm * tstep + (size_t)cur.kt0 * kstepA; const char* cB = (const char*)g.Bt + (size_t)cur.pn * tstep + (size_t)cur.kt0 * kstepB;
    S.a_ready(cur);
    if constexpr (SP2) {
        PG8_STAGE(PG8_SB(0, 0), cB, voffB); PG8_STAGE(PG8_SB(0, 1), cB + hstepB, voffB); PG8_STAGE_A(PG8_SA(0, 0), cA, voffA); PG8_STAGE_A(PG8_SA(0, 1), cA + hstepA, voffA);
        if (wr == 1) PG8_BAR;
        PG8_WAIT_V(2); PG8_BAR;
        PG8_STAGE(PG8_SB(1, 0), cB + kstepB, voffB); PG8_STAGE_A(PG8_SA(1, 0), cA + kstepA, voffA); PG8_STAGE(PG8_SB(1, 1), cB + hstepB + kstepB, voffB);
        PG8_WAIT_V(6); PG8_BAR;
    } else {
        PG8_STAGE(PG8_SB(0, 0), cB, voffB); PG8_STAGE_A(PG8_SA(0, 0), cA, voffA); PG8_STAGE(PG8_SB(0, 1), cB + hstepB, voffB); PG8_STAGE_A(PG8_SA(0, 1), cA + hstepA, voffA);
        if (wr == 1) PG8_BAR;
        PG8_WAIT_V(4); PG8_BAR;
        PG8_STAGE(PG8_SB(1, 0), cB + kstepB, voffB); PG8_STAGE_A(PG8_SA(1, 0), cA + kstepA, voffA); PG8_STAGE(PG8_SB(1, 1), cB + hstepB + kstepB, voffB);
        PG8_WAIT_V(6); PG8_BAR;
    }
    for (;;) {
        const bool has_next = S.next(ui + 1, nxt);
        const char* nA = has_next ? (const char*)g.A + (size_t)nxt.pm * tstep + (size_t)nxt.kt0 * kstepA : cA; const char* nB = has_next ? (const char*)g.Bt + (size_t)nxt.pn * tstep + (size_t)nxt.kt0 * kstepB : cB;
        for (int t = 0; t < nt; t += 2) {
            const bool last = (t == nt - 2);
            const char* a1 = cA + (size_t)(t + 1) * kstepA;
            const char* a2 = last ? nA : cA + (size_t)(t + 2) * kstepA; const char* b2 = last ? nB : cB + (size_t)(t + 2) * kstepB;
            const char* a3 = a2 + kstepA; const char* b3 = b2 + kstepB;
            if (last && has_next) S.a_ready(nxt);
            if constexpr (SP2) {
            PG8_LDB(B0, 0, 0); PG8_LDB(B1, 0, 1); PG8_SCHED; PG8_LDA(At, 0, 0); PG8_STAGE_A(PG8_SA(1, 1), a1 + hstepA, voffA);
            PG8_WAIT_V(8); PG8_WAIT_L(0); PG8_BAR; PG8_MMA(0, 0, At, B0); PG8_MMA(0, 1, At, B1); PG8_BAR; PG8_SCHED;
            PG8_LDA(At, 0, 1); PG8_STAGE(PG8_SB(0, 0), b2, voffB); PG8_STAGE(PG8_SB(0, 1), b2 + hstepB, voffB); PG8_STAGE_A(PG8_SA(0, 0), a2, voffA);
            PG8_WAIT_V(8); PG8_WAIT_L(0); PG8_BAR; PG8_MMA(1, 0, At, B0); PG8_MMA(1, 1, At, B1); PG8_BAR; PG8_SCHED;
            PG8_LDB(B0, 1, 0); PG8_LDB(B1, 1, 1); PG8_SCHED; PG8_LDA(At, 1, 0); PG8_STAGE_A(PG8_SA(0, 1), a2 + hstepA, voffA);
            PG8_WAIT_V(8); PG8_WAIT_L(0); PG8_BAR; PG8_MMA(0, 0, At, B0); PG8_MMA(0, 1, At, B1); PG8_BAR; PG8_SCHED;
            PG8_LDA(At, 1, 1); PG8_STAGE(PG8_SB(1, 0), b3, voffB); PG8_STAGE(PG8_SB(1, 1), b3 + hstepB, voffB); PG8_STAGE_A(PG8_SA(1, 0), a3, voffA);
            PG8_WAIT_V(8); PG8_WAIT_L(0); PG8_BAR; PG8_MMA(1, 0, At, B0); PG8_MMA(1, 1, At, B1); PG8_BAR; PG8_SCHED;
            } else {
            PG8_LDB(B0, 0, 0); PG8_SCHED; PG8_LDA(At, 0, 0); PG8_STAGE_A(PG8_SA(1, 1), a1 + hstepA, voffA);
            PG8_WAIT_L(8); PG8_BAR; PG8_WAIT_L(0); PG8_MMA(0, 0, At, B0); PG8_BAR; PG8_SCHED;
            PG8_LDB(B1, 0, 1); PG8_STAGE(PG8_SB(0, 0), b2, voffB);
            PG8_BAR; PG8_WAIT_L(0); PG8_MMA(0, 1, At, B1); PG8_BAR;
            PG8_LDA(At, 0, 1); PG8_STAGE_A(PG8_SA(0, 0), a2, voffA);
            PG8_BAR; PG8_WAIT_L(0); PG8_MMA(1, 0, At, B0); PG8_BAR; PG8_SCHED;
            PG8_STAGE(PG8_SB(0, 1), b2 + hstepB, voffB);
            PG8_WAIT_V(6); PG8_BAR; PG8_MMA(1, 1, At, B1); PG8_BAR;
            PG8_LDB(B0, 1, 0); PG8_SCHED; PG8_LDA(At, 1, 0); PG8_STAGE_A(PG8_SA(0, 1), a2 + hstepA, voffA);
            PG8_WAIT_L(8); PG8_BAR; PG8_WAIT_L(0); PG8_MMA(0, 0, At, B0); PG8_BAR; PG8_SCHED;
            PG8_LDB(B1, 1, 1); PG8_STAGE(PG8_SB(1, 0), b3, voffB);
            PG8_BAR; PG8_WAIT_L(0); PG8_MMA(0, 1, At, B1); PG8_BAR;
            PG8_LDA(At, 1, 1); PG8_STAGE_A(PG8_SA(1, 0), a3, voffA);
            PG8_BAR; PG8_WAIT_L(0); PG8_MMA(1, 0, At, B0); PG8_BAR; PG8_SCHED;
            PG8_STAGE(PG8_SB(1, 1), b3 + hstepB, voffB);
            PG8_WAIT_V(6); PG8_BAR; PG8_MMA(1, 1, At, B1); PG8_BAR;
            }
        }
        if constexpr (ALIGN_EPI) { if (wr == 0) PG8_BAR; }
        bool chain = false; if constexpr (Epi::MIDK) chain = (cur.aux == 1);
        if constexpr (Epi::MIDK) { if (chain) E.midk(acc, cur, wr, fr); }
        if constexpr (!Epi::AFTER_DRAIN) { if (!chain) { E(acc, cur, wr, wc, fr, fq); S.done(cur); } }
        if (!has_next) break;
        if (!chain) {
#pragma unroll
        for (int a = 0; a < 2; ++a)
#pragma unroll
            for (int b = 0; b < 2; ++b)
#pragma unroll
                for (int m = 0; m < 4; ++m)
#pragma unroll
                    for (int n = 0; n < 2; ++n) acc[a][b][m][n] = (f32x4){0.f, 0.f, 0.f, 0.f};
        }
        cur = nxt; cA = nA; cB = nB; ++ui; nt = cur.nt;
        if constexpr (ALIGN_EPI) { if (wr == 1) PG8_BAR; }
    }
    PG8_WAIT_V(0);
    if constexpr (!ALIGN_EPI) { if (wr == 0) PG8_BAR; }
    PG8_BAR;
    if constexpr (Epi::AFTER_DRAIN) { E.fused(acc, cur, wr, wc, fr, fq, lds, wid, lane); S.done(cur); }
#undef PG8_SA
#undef PG8_SB
#undef PG8_STAGE
#undef PG8_STAGE_A
#undef PG8_LDA
#undef PG8_LDB
#undef PG8_MMA
#undef PG8_WAIT_V
#undef PG8_WAIT_L
#undef PG8_BAR
#undef PG8_SCHED
}
}
#ifndef PG8_SP2
#define PG8_SP2 true
#endif
#ifndef PG8_ALIGN
#define PG8_ALIGN true
#endif
#ifndef MK_N_LAUNCHES
#define MK_N_LAUNCHES 1
#endif
constexpr int N_LAUNCHES = MK_N_LAUNCHES;
constexpr int N_PHASES = 11;
constexpr int NWAVES = 8;

constexpr int DM = 4096, SEQ = 2048, NBP = 4, MP = NBP * SEQ, NBS = 128, LS = 8, MS = NBS * LS, M = MP + MS;
constexpr int C_Q = 0, C_K = 2048, C_V = 2560, C_Z = 3072, C_X = 5120, C_DT = 9216, LDP = 9472;
constexpr int DFF = 11008, NGU = 2 * DFF;
constexpr float EPS = 1e-6f, LOG2E = 1.4426950408889634f;

constexpr size_t O_YP = 0, O_YS = 33554432, O_PK = 37748736, O_PV = 38010880, O_PSSM = 38273024, O_PCONV = 39321600, O_PFFN = 39370752,
                 O_SK = 39458816, O_SV = 47847424, O_SSSM = 56236032, O_SCONV = 89790464, O_SFFN = 91363328, O_END = 94181376;

constexpr size_t MiB = 1u << 20;
constexpr size_t WS_CTL = 0, CTL_ZERO_BYTES = 1 * MiB;
constexpr size_t WS_W3 = 2 * MiB;
constexpr size_t WS_W4 = 174 * MiB;
constexpr size_t WS_XN = 260 * MiB;
constexpr size_t WS_W1 = 332 * MiB;
constexpr size_t WS_W2 = 406 * MiB;
constexpr size_t WS_PROJ = 438 * MiB;
constexpr size_t WS_MIX = 605 * MiB;
constexpr size_t WS_GU = 332 * MiB;
constexpr size_t WS_ACT = 719 * MiB;
constexpr size_t WS_SLAB = 332 * MiB;
constexpr size_t WS_XBCC = 332 * MiB;
constexpr size_t WS_FIX = 680 * MiB;
constexpr size_t WS_END = 913 * MiB;
static_assert(WS_W3 + (size_t)NGU * DM * 2 <= WS_W4 && WS_W4 + (size_t)DM * DFF * 2 <= WS_XN && WS_XN + (size_t)M * DM * 2 <= WS_W1 && WS_W1 + (size_t)LDP * DM * 2 <= WS_W2 &&
              WS_W2 + (size_t)DM * DM * 2 <= WS_PROJ && WS_PROJ + (size_t)M * LDP * 2 <= WS_MIX && WS_MIX + (size_t)M * DM * 2 <= WS_ACT && WS_GU + (size_t)M * NGU * 2 <= WS_ACT &&
              WS_ACT + (size_t)M * DFF * 2 <= WS_END, "d_ws map");

constexpr int CW_TMO = 0, CW_CODE = 1, CW_BAR = 4096, CW_Q = 8192  , CW_SSQ = 16384  , CW_SSQ2 = 36864  ;

constexpr int RING_OFF = 0, RING_BYTES = 131072;
constexpr int TB_OFF = 131072;
constexpr int CWL_OFF = TB_OFF + 8192;
constexpr int LDSCTL_OFF = CWL_OFF + 6400, MISC_OFF = LDSCTL_OFF + 320;
constexpr int LDS_BYTES = 147456;
static_assert(MISC_OFF + 128 <= LDS_BYTES && (MISC_OFF % 16) == 0, "LDS map");

#define GAS __attribute__((address_space(1)))
#define LAS __attribute__((address_space(3)))
typedef unsigned short bf16;
typedef unsigned u32x4 __attribute__((ext_vector_type(4)));
typedef unsigned u32x2 __attribute__((ext_vector_type(2)));
typedef float f32x4 __attribute__((ext_vector_type(4)));
typedef float f32x16 __attribute__((ext_vector_type(16)));
typedef short bf16x8 __attribute__((ext_vector_type(8)));
typedef short s16x4 __attribute__((ext_vector_type(4)));
typedef short v4i16_t __attribute__((ext_vector_type(4)));
typedef GAS unsigned gu32;
#define RLX_AGENT __ATOMIC_RELAXED, __HIP_MEMORY_SCOPE_AGENT
#define LDS_WAIT() asm volatile("s_waitcnt lgkmcnt(0)" ::: "memory")
#define VM_WAIT() asm volatile("s_waitcnt vmcnt(0)" ::: "memory")
#define MFMA32(a, b, c) __builtin_amdgcn_mfma_f32_32x32x16_bf16((a), (b), (c), 0, 0, 0)
typedef float f32x2_t __attribute__((ext_vector_type(2)));
typedef __bf16 bf16x2_t __attribute__((ext_vector_type(2)));
__device__ __forceinline__ unsigned cvtpk(float lo, float hi) { f32x2_t v = {lo, hi}; bf16x2_t b = __builtin_convertvector(v, bf16x2_t); return __builtin_bit_cast(unsigned, b); }
__device__ __forceinline__ float bf2f(unsigned short h) { return __uint_as_float((unsigned)h << 16); }
__device__ __forceinline__ float bflo(unsigned w) { return __uint_as_float(w << 16); }
__device__ __forceinline__ float bfhi(unsigned w) { return __uint_as_float(w & 0xffff0000u); }
__device__ __forceinline__ void unpack8(const u32x4 w, float (&f)[8]) { f[0] = bflo(w.x); f[1] = bfhi(w.x); f[2] = bflo(w.y); f[3] = bfhi(w.y); f[4] = bflo(w.z); f[5] = bfhi(w.z); f[6] = bflo(w.w); f[7] = bfhi(w.w); }
__device__ __forceinline__ u32x4 pack8(const float (&f)[8]) { u32x4 w; w.x = cvtpk(f[0], f[1]); w.y = cvtpk(f[2], f[3]); w.z = cvtpk(f[4], f[5]); w.w = cvtpk(f[6], f[7]); return w; }
__device__ __forceinline__ float silu_f(float x) { return x * __builtin_amdgcn_rcpf(1.0f + __expf(-x)); }
__device__ __forceinline__ float softplus_f(float x) { return x > 20.f ? x : log1pf(__expf(x)); }
__device__ __forceinline__ int crow(int r, int hi) { return (r & 3) + 8 * (r >> 2) + 4 * hi; }
__device__ __forceinline__ s16x4 vtr(const LAS unsigned char* p) { return __builtin_bit_cast(s16x4, __builtin_amdgcn_ds_read_tr16_b64_v4i16((LAS v4i16_t*)p)); }
__device__ __forceinline__ bf16x8 cat4(s16x4 a, s16x4 b) { bf16x8 r; r[0] = a[0]; r[1] = a[1]; r[2] = a[2]; r[3] = a[3]; r[4] = b[0]; r[5] = b[1]; r[6] = b[2]; r[7] = b[3]; return r; }
__device__ __forceinline__ bf16x8 pack_step(const f32x16& x, int s) {
    u32x4 p; p.x = cvtpk(x[8 * s], x[8 * s + 1]); p.y = cvtpk(x[8 * s + 2], x[8 * s + 3]); p.z = cvtpk(x[8 * s + 4], x[8 * s + 5]); p.w = cvtpk(x[8 * s + 6], x[8 * s + 7]);
    return __builtin_bit_cast(bf16x8, p);
}
__device__ __forceinline__ float wave_sum(float v) {
#pragma unroll
    for (int o = 1; o < 64; o <<= 1) v += __shfl_xor(v, o);
    return v;
}

struct Args { const float* in[26]; float* out; unsigned char* ws; int ph_lo, ph_hi, grid, pad; };
#define KARG ((const __attribute__((address_space(4))) Args*)__builtin_amdgcn_kernarg_segment_ptr())
#define P_x_prompt (KARG->in[0])
#define P_x_sample (KARG->in[1])
#define P_st_k (KARG->in[2])
#define P_st_v (KARG->in[3])
#define P_st_ssm (KARG->in[4])
#define P_st_conv (KARG->in[5])
#define P_st_ffn (KARG->in[6])
#define P_rel_bias (KARG->in[7])
#define P_mix_nw (KARG->in[8])
#define P_w_in (KARG->in[9])
#define P_q_nw (KARG->in[10])
#define P_k_nw (KARG->in[11])
#define P_sinks (KARG->in[12])
#define P_conv_w (KARG->in[13])
#define P_conv_b (KARG->in[14])
#define P_dt_bias (KARG->in[15])
#define P_A_log (KARG->in[16])
#define P_Dv (KARG->in[17])
#define P_ssd_nw (KARG->in[18])
#define P_w_out (KARG->in[19])
#define P_ffn_nw (KARG->in[20])
#define P_w_gate (KARG->in[21])
#define P_w_up (KARG->in[22])
#define P_fconv_w (KARG->in[23])
#define P_fconv_b (KARG->in[24])
#define P_w_down (KARG->in[25])
#define P_out (KARG->out)
#define P_ws (KARG->ws)
#define P_W1 ((bf16*)(P_ws + WS_W1))
#define P_W2 ((bf16*)(P_ws + WS_W2))
#define P_W3 ((bf16*)(P_ws + WS_W3))
#define P_W4 ((bf16*)(P_ws + WS_W4))
#define P_XN ((bf16*)(P_ws + WS_XN))
#define P_PROJ ((bf16*)(P_ws + WS_PROJ))
#define P_MIX ((bf16*)(P_ws + WS_MIX))
#define P_ACT ((bf16*)(P_ws + WS_ACT))
#define P_X1B ((bf16*)(P_ws + WS_PROJ))
#define P_ssq2 ((float*)(P_ws + WS_CTL) + CW_SSQ2)
#define P_ctl ((gu32*)(P_ws + WS_CTL))
#define P_ssq ((float*)(P_ws + WS_CTL) + CW_SSQ)
struct Ptrs {};

namespace pg8 {
__device__ __forceinline__ float dpp_shr1(float old, float src) { return __builtin_bit_cast(float, __builtin_amdgcn_update_dpp(__builtin_bit_cast(int, old), __builtin_bit_cast(int, src), 0x111, 0xf, 0xf, false)); }
__device__ __forceinline__ float dpp_shr2(float old, float src) { return __builtin_bit_cast(float, __builtin_amdgcn_update_dpp(__builtin_bit_cast(int, old), __builtin_bit_cast(int, src), 0x112, 0xf, 0xf, false)); }
__device__ __forceinline__ float dpp_ror1(float src) { return __builtin_bit_cast(float, __builtin_amdgcn_update_dpp(0, __builtin_bit_cast(int, src), 0x121, 0xf, 0xf, false)); }
__device__ __forceinline__ float dpp_ror2(float src) { return __builtin_bit_cast(float, __builtin_amdgcn_update_dpp(0, __builtin_bit_cast(int, src), 0x122, 0xf, 0xf, false)); }
__device__ __forceinline__ size_t act_off(int r, int j) { return ((size_t)((r >> 8) * (DFF / 64) + (j >> 6)) * 256 + (r & 255)) * 64 + (j & 63); }
__device__ __forceinline__ float silu_e(float x) { return x * __builtin_amdgcn_rcpf(1.0f + __expf(-x)); }
struct EpiGateUp {
    static constexpr bool PERM = true, AFTER_DRAIN = false, MIDK = false;
    bf16_t* ACT; const float* cw; const float* cb; const float* st_ffn; float* fix; float* out; PG8_LAS float* E; const float* ssq;
    __device__ __forceinline__ void operator()(const f32x4 (&acc)[2][2][4][2], const Unit& u, int wr, int wc, int fr, int fq) const {
        asm volatile("" : "+v"(fr), "+v"(fq));
        const int jl = wc * 32 + 8 * fq, j0 = u.pn * 128 + jl;
        const bool sample = u.pm >= MP / 256;
        const float* sq = ssq + u.pm * BM + wr * 64 + fr;
#define RSTD(ai_, m_) (1.0f / sqrtf(sq[(ai_) * HALF + (m_) * 16] * (1.0f / DM) + EPS))
        { const int tid_ = threadIdx.x; if (tid_ < 256) E[1024 + tid_] = 1.0f / sqrtf(ssq[u.pm * BM + tid_] * (1.0f / DM) + EPS); }
        if (fr >= 14) {
#pragma unroll
            for (int ai = 0; ai < 2; ++ai)
#pragma unroll
                for (int n = 0; n < 2; ++n) *(PG8_LAS f32x4*)(E + ((ai * 2 + wr) * 2 + (fr - 14)) * 128 + jl + 4 * n) = acc[ai][0][3][n] * RSTD(ai, 3);
            if (!sample && wr == 1) {
#pragma unroll
                for (int n = 0; n < 2; ++n) { const f32x4 gh = acc[1][0][3][n] * RSTD(1, 3); *(f32x4*)(fix + ((size_t)u.pm * 2 + (fr - 14)) * DFF + j0 + 4 * n) = gh;
                    if ((u.pm & 7) == 7) *(f32x4*)(out + O_PFFN + ((size_t)(u.pm >> 3) * 2 + (fr - 14)) * DFF + j0 + 4 * n) = gh; }
            }
        }
        asm volatile("s_waitcnt lgkmcnt(0)" ::: "memory"); __builtin_amdgcn_s_barrier(); asm volatile("" ::: "memory");
#pragma unroll
        for (int n = 0; n < 2; ++n) {
            const f32x4 w0 = *(const f32x4*)(cw + j0 + 4 * n), w1 = *(const f32x4*)(cw + DFF + j0 + 4 * n), w2 = *(const f32x4*)(cw + 2 * DFF + j0 + 4 * n), bb = *(const f32x4*)(cb + j0 + 4 * n);
#pragma unroll
            for (int ai = 0; ai < 2; ++ai) {
                const PG8_LAS float* RS = E + 1024 + ai * HALF + wr * 64 + fr;
                f32x4 bm1 = (f32x4){0.f, 0.f, 0.f, 0.f}, bm2 = bm1;
                if (!sample && (wr == 1 || ai == 1)) { const int sa = (wr == 1) ? ai : 0, sw = (wr == 1) ? 0 : 1;
                    bm2 = *(const PG8_LAS f32x4*)(E + ((sa * 2 + sw) * 2 + 0) * 128 + jl + 4 * n); bm1 = *(const PG8_LAS f32x4*)(E + ((sa * 2 + sw) * 2 + 1) * 128 + jl + 4 * n); }
#pragma unroll
                for (int m = 0; m < 4; ++m) {
                    const int r = u.pm * BM + ai * HALF + wr * 64 + m * 16 + fr;
                    const float rsm = RS[16 * m]; const f32x4 g = acc[ai][0][m][n] * rsm, uu = acc[ai][1][m][n] * rsm; f32x4 p1, p2, av;
                    if (!sample) {
#pragma unroll
                        for (int e = 0; e < 4; ++e) { float o1, o2;
                            if (m == 0) { o1 = bm1[e]; o2 = (fr == 0) ? bm2[e] : bm1[e]; } else { const float gp = acc[ai][0][m > 0 ? m - 1 : 0][n][e] * RS[16 * (m > 0 ? m - 1 : 0)]; o1 = dpp_ror1(gp); o2 = dpp_ror2(gp); }
                            p1[e] = dpp_shr1(o1, g[e]); p2[e] = dpp_shr2(o2, g[e]); }
                        if (ai == 0 && wr == 0 && m == 0 && fr < 2 && (u.pm & 7) != 0) {
                            *(f32x4*)(fix + ((size_t)(72 + u.pm * 2 + fr)) * DFF + j0 + 4 * n) = g; *(f32x4*)(fix + ((size_t)(144 + u.pm * 2 + fr)) * DFF + j0 + 4 * n) = uu; }
                    } else {
                        const int t = fr & 7, bs = (r - MP) >> 3; f32x4 s0 = (f32x4){0.f, 0.f, 0.f, 0.f}, s1 = s0;
                        if (t < 2) { s0 = *(const f32x4*)(st_ffn + ((size_t)bs * 2 + 0) * DFF + j0 + 4 * n); s1 = *(const f32x4*)(st_ffn + ((size_t)bs * 2 + 1) * DFF + j0 + 4 * n); }
#pragma unroll
                        for (int e = 0; e < 4; ++e) { const float a1 = dpp_shr1(0.f, g[e]), a2 = dpp_shr2(0.f, g[e]); p1[e] = (t >= 1) ? a1 : s1[e]; p2[e] = (t >= 2) ? a2 : (t == 1 ? s1[e] : s0[e]); }
                        if (t >= 6) *(f32x4*)(out + O_SFFN + ((size_t)bs * 2 + (t - 6)) * DFF + j0 + 4 * n) = g;
                    }
                    const f32x4 gc = bb + w0 * p2 + w1 * p1 + w2 * g;
#pragma unroll
                    for (int e = 0; e < 4; ++e) av[e] = silu_e(gc[e]) * uu[e];
                    typedef unsigned u32x2e __attribute__((ext_vector_type(2)));
                    u32x2e w; w.x = cvt_pk_bf16(av[0], av[1]); w.y = cvt_pk_bf16(av[2], av[3]);
                    *(u32x2e*)(ACT + act_off(r, j0 + 4 * n)) = w;
                }
            }
        }
#undef RSTD
    }
};
}
#define XB_TMO      128
#define XB_XCNT(j)  (256  + 64 * (j))
#define XB_XSUB(j)  (1280 + 64 * (j))
#define XB_XGEN(j)  (2304 + 64 * (j))
#define XB_TOP      3328
#define XB_TOPGEN   3392
#define XCD_BAR_WORDS 3456
#define XB_SPIN_CAP (1u << 18)

__device__ __forceinline__ unsigned xb_ld(unsigned* p)              { return __hip_atomic_load(p, __ATOMIC_RELAXED, __HIP_MEMORY_SCOPE_AGENT); }
__device__ __forceinline__ unsigned xb_add(unsigned* p, unsigned v) { return __hip_atomic_fetch_add(p, v, __ATOMIC_RELAXED, __HIP_MEMORY_SCOPE_AGENT); }
__device__ __forceinline__ unsigned xb_xcc_id() { return (unsigned)__builtin_amdgcn_s_getreg((3 << 11) | 20) & 0xFu; }
#define XB_SPIN(cond, bar) do { unsigned _sp = 0; while (cond) { __builtin_amdgcn_s_sleep(1); \
    if ((++_sp & 255u) == 0u) { if (xb_ld(&(bar)[XB_TMO])) break; if (_sp > XB_SPIN_CAP) { atomicAdd(&(bar)[XB_TMO], 1u); break; } } } } while (0)

struct XcdBarrier {
    unsigned* bar; unsigned x;
    volatile LAS unsigned* st;
};

__device__ __forceinline__ XcdBarrier xcd_barrier_post(unsigned* bar, volatile LAS unsigned* st) {
    XcdBarrier b; b.bar = bar; b.x = xb_xcc_id(); b.st = st;
    if (threadIdx.x == 0) (void)xb_add(&bar[XB_XCNT(b.x)], 1u);
    return b;
}
__device__ __forceinline__ void xcd_barrier_complete(unsigned* bar, unsigned x, unsigned& nloc, unsigned& nx) {
    const unsigned G = (unsigned)KARG->grid;
    unsigned sum, cnt, mine, sp = 0u;
    for (;;) {
        sum = 0u; cnt = 0u; mine = 0u;
#pragma unroll
        for (unsigned j = 0; j < 16; ++j) { const unsigned c = xb_ld(&bar[XB_XCNT(j)]); sum += c; cnt += (c > 0u) ? 1u : 0u; mine = (j == x) ? c : mine; }
        if (sum == G) break;
        __builtin_amdgcn_s_sleep(1);
        if ((++sp & 255u) == 0u) { if (xb_ld(&bar[XB_TMO])) break; if (sp > XB_SPIN_CAP) { atomicAdd(&bar[XB_TMO], 1u); break; } }
    }
    nloc = mine > 0u ? mine : 1u; nx = cnt > 0u ? cnt : 1u;
}

__device__ __forceinline__ void xcd_barrier(const XcdBarrier& b) {
    asm volatile("s_waitcnt vmcnt(0)" ::: "memory");
    __syncthreads();
    if (threadIdx.x == 0) {
        unsigned* bar = b.bar;
        __builtin_amdgcn_s_waitcnt(0);
        unsigned nloc = b.st[0], nx = b.st[1];
        if (nloc == 0u) { xcd_barrier_complete(bar, b.x, nloc, nx); b.st[0] = nloc; b.st[1] = nx; }
        const unsigned old = xb_add(&bar[XB_XSUB(b.x)], 1u);
        const unsigned gen = old / nloc;
        if (old + 1u == (gen + 1u) * nloc) {
            __builtin_amdgcn_fence(__ATOMIC_RELEASE, "agent");
            asm volatile("s_waitcnt vmcnt(0)" ::: "memory");
            const unsigned og = xb_add(&bar[XB_TOP], 1u);
            const unsigned tg = og / nx;
            if (og + 1u == (tg + 1u) * nx) xb_add(&bar[XB_TOPGEN], 1u);
            else XB_SPIN(xb_ld(&bar[XB_TOPGEN]) == tg, bar);
            __builtin_amdgcn_fence(__ATOMIC_ACQUIRE, "agent");
            xb_add(&bar[XB_XGEN(b.x)], 1u);
            asm volatile("s_waitcnt vmcnt(0)" ::: "memory");
        } else {
            XB_SPIN(xb_ld(&bar[XB_XGEN(b.x)]) == gen, bar);
            __builtin_amdgcn_fence(__ATOMIC_ACQUIRE, "agent");
            asm volatile("s_waitcnt vmcnt(0)" ::: "memory");
        }
    }
    __syncthreads();
}


struct Frame { LAS unsigned char* lds; int tid, lane, wave, G, bid; };

#define LBAR() do { asm volatile("s_waitcnt lgkmcnt(0)" ::: "memory"); __builtin_amdgcn_s_barrier(); asm volatile("" ::: "memory"); } while (0)
__device__ __forceinline__ int wq_next(gu32* ctr, volatile LAS unsigned* slot, int tid) {
    LBAR();
    if (tid == 0) *slot = __hip_atomic_fetch_add(ctr, 1u, RLX_AGENT);
    LBAR();
    return (int)*slot;
}

__device__ __forceinline__ void p0_transpose_item(const float* W, int K, int N, bf16* WT, int mode, LAS float* scr, int item, int lane, const float* kscale = nullptr) {
    const int nblk = N / 32, kb = item / nblk, nb = item % nblk, k0 = 64 * kb, n0 = 32 * nb;
    const int rb = (mode == 0 || mode == 3 || mode == 4) ? n0 : ((n0 >> 7) * 256 + (n0 & 127) + (mode == 2 ? 128 : 0));
    float wv[32];
#pragma unroll
    for (int i = 0; i < 32; ++i) wv[i] = W[(size_t)(k0 + 2 * i + (lane >> 5)) * N + n0 + (lane & 31)];
#pragma unroll
    for (int i = 0; i < 32; ++i) scr[(2 * i + (lane >> 5)) * 33 + (lane & 31)] = wv[i];
    LDS_WAIT(); asm volatile("" ::: "memory");
    const int c = lane & 7;
    f32x4 ks0 = (f32x4){1.f, 1.f, 1.f, 1.f}, ks1 = ks0; if (kscale) { ks0 = *(const f32x4*)(kscale + k0 + 8 * c); ks1 = *(const f32x4*)(kscale + k0 + 8 * c + 4); }
#pragma unroll
    for (int j = 0; j < 4; ++j) { const int n = (lane >> 3) + 8 * j; const LAS float* s = scr + (8 * c) * 33 + n;
        u32x4 o; o.x = cvtpk(s[0 * 33] * ks0.x, s[1 * 33] * ks0.y); o.y = cvtpk(s[2 * 33] * ks0.z, s[3 * 33] * ks0.w); o.z = cvtpk(s[4 * 33] * ks1.x, s[5 * 33] * ks1.y); o.w = cvtpk(s[6 * 33] * ks1.z, s[7 * 33] * ks1.w);
        const int k0d = (mode == 4) ? ((k0 + 2048) & 4095) : k0;
        const size_t dst = (mode == 3) ? ((size_t)(((rb + n) >> 8) * (K >> 6) + kb) * 256 + ((rb + n) & 255)) * 64 + 8 * c : (size_t)(rb + n) * K + k0d + 8 * c;
        *(u32x4*)(WT + dst) = o; }
    LDS_WAIT(); asm volatile("" ::: "memory");
}
__device__ __forceinline__ void rms_regs_to_bf16(const f32x4 (&v)[16], const float* w, bf16* orow, int lane) {
    float s = 0.f;
#pragma unroll
    for (int j = 0; j < 16; ++j) s += (v[j].x * v[j].x + v[j].y * v[j].y) + (v[j].z * v[j].z + v[j].w * v[j].w);
    const float rstd = 1.0f / sqrtf(wave_sum(s) * (1.0f / DM) + EPS);
    const f32x4* wr = (const f32x4*)w + lane; u32x2* o8 = (u32x2*)orow + lane;
#pragma unroll
    for (int j = 0; j < 16; ++j) { const f32x4 wv = wr[64 * j]; u32x2 o; o.x = cvtpk(v[j].x * rstd * wv.x, v[j].y * rstd * wv.y); o.y = cvtpk(v[j].z * rstd * wv.z, v[j].w * rstd * wv.w); o8[64 * j] = o; }
}
__device__ __forceinline__ void rms_row_to_bf16(const float* xrow, const float* w, bf16* orow, int lane) {
    const f32x4* xr = (const f32x4*)xrow + lane; f32x4 v[16];
#pragma unroll
    for (int j = 0; j < 16; ++j) v[j] = xr[64 * j];
    rms_regs_to_bf16(v, w, orow, lane);
}
constexpr int I_1 = (DM / 64) * (9248 / 32), I_2 = (DM / 64) * (DM / 32), I_3 = (DM / 64) * (DFF / 32), I_4 = (DFF / 64) * (DM / 32);
template <int WHICH> __device__ __forceinline__ void convert_weights(const Frame& F, int gw, int ngw) {
    LAS float* scr = (LAS float*)(F.lds + RING_OFF + F.wave * 16384);
    constexpr int NIT = WHICH == 0 ? I_1 + I_2 : (WHICH == 3 ? 2 * I_3 : I_4);
    for (int it = gw; it < NIT; it += ngw) {
        if (WHICH == 0) { if (it < I_1) p0_transpose_item(P_w_in, DM, 9248, P_W1, 0, scr, it, F.lane); else p0_transpose_item(P_w_out, DM, DM, P_W2, 4, scr, it - I_1, F.lane); }
        else if (WHICH == 3) { if (it < I_3) p0_transpose_item(P_w_gate, DM, DFF, P_W3, 1, scr, it, F.lane, P_ffn_nw); else p0_transpose_item(P_w_up, DM, DFF, P_W3, 2, scr, it - I_3, F.lane, P_ffn_nw); }
        else p0_transpose_item(P_w_down, DFF, DM, P_W4, 0, scr, it, F.lane);
    }
}
template <int WHICH> __device__ __forceinline__ void convert_weights_dyn(const Frame& F, gu32* ctr) {
    LAS float* scr = (LAS float*)(F.lds + RING_OFF + F.wave * 16384);
    constexpr int NIT = WHICH == 3 ? 2 * I_3 : I_4;
    for (;;) {
        unsigned v = 0u; if (F.lane == 0) v = __hip_atomic_fetch_add(ctr, 8u, RLX_AGENT);
        const int it0 = (int)__builtin_amdgcn_readfirstlane(v); if (it0 >= NIT) break;
#pragma unroll 1
        for (int k = 0; k < 8; ++k) { const int it = it0 + k; if (it >= NIT) break;
            if (WHICH == 3) { if (it < I_3) p0_transpose_item(P_w_gate, DM, DFF, P_W3, 1, scr, it, F.lane, P_ffn_nw); else p0_transpose_item(P_w_up, DM, DFF, P_W3, 2, scr, it - I_3, F.lane, P_ffn_nw); }
            else p0_transpose_item(P_w_down, DFF, DM, P_W4, 0, scr, it, F.lane); }
    }
}
template <int WHICH> __device__ __forceinline__ void tail_filler(const Frame& F, int nunits) {
    const int extra = nunits % F.G; const int first = extra, nhelp = F.G - extra;
    if (F.bid >= first) convert_weights<WHICH>(F, (F.bid - first) * NWAVES + F.wave, nhelp * NWAVES);
}
__device__ __forceinline__ void p0_prologue(const Frame& F, const Ptrs& P) {
    const int gw = F.bid * NWAVES + F.wave, NGW = F.G * NWAVES;
    convert_weights<0>(F, gw, NGW);
    for (int m = gw; m < M; m += NGW) { const float* xr = (m < MP) ? P_x_prompt + (size_t)m * DM : P_x_sample + (size_t)(m - MP) * DM; rms_row_to_bf16(xr, P_mix_nw, P_XN + (size_t)m * DM, F.lane); }
}

#ifdef PROBE_A
#ifndef PROBE_MULT
#define PROBE_MULT 8
#endif
#ifndef PROBE_BID
#define PROBE_BID 0
#endif
#define STAMP(i) do { if (F.bid == PROBE_BID && F.tid == 0 && ((i) == PROBE_A || (i) == PROBE_B)) { const unsigned long long t_ = __builtin_amdgcn_s_memrealtime(); volatile LAS unsigned* m_ = (volatile LAS unsigned*)(F.lds + MISC_OFF) + ((i) == PROBE_A ? 16 : 18); m_[0] = (unsigned)t_; m_[1] = (unsigned)(t_ >> 32); } } while (0)
#else
#define STAMP(i) do { } while (0)
#endif
#ifndef NREP_P0
#define NREP_P0 1
#endif
#ifndef NREP_MIX
#define NREP_MIX 1
#endif
#ifndef MIXDUP_A
#define MIXDUP_A 1
#endif
#ifndef MIXDUP_B
#define MIXDUP_B 1
#endif
#ifndef MIXDUP_C
#define MIXDUP_C 1
#endif
#ifndef MIXDUP_D
#define MIXDUP_D 1
#endif
#if NREP_MIX > 1
#define SSQ_REP_OFF (*(volatile LAS unsigned*)(F.lds + MISC_OFF + 20))
#else
#define SSQ_REP_OFF 0
#endif
constexpr int KS = 272, VS = 320;
__device__ __forceinline__ int t5_bucket(int n) { if (n < 16) return n; const float v = logf((float)n / 16.0f) / 2.0794415f * 16.0f; const int l = 16 + (int)v; return l < 31 ? l : 31; }

template <int ND> __device__ __forceinline__ void attn_task(const LAS unsigned char* Kl, const LAS unsigned char* Vl, int kt0, const bf16x8 (&qf)[8], int d0, int jmin, const LAS float* tb, float sink2, bf16* outp, int lane, int db) {
    const int q = lane & 31, hi = lane >> 5;
    asm volatile("" : "+v"(d0));
    f32x16 st[5];
#pragma unroll
    for (int t = 0; t < 5; ++t) {
        f32x16 a; for (int i = 0; i < 16; ++i) a[i] = 0.f;
        const LAS unsigned char* kp = Kl + ((kt0 + t) * 32 + q) * KS + hi * 16;
        bf16x8 kfr[8];
#pragma unroll
        for (int ks = 0; ks < 8; ++ks) kfr[ks] = *(const LAS bf16x8*)(kp + ks * 32);
#pragma unroll
        for (int ks = 0; ks < 8; ++ks) a = MFMA32(kfr[ks], qf[ks], a);
        st[t] = a; __builtin_amdgcn_sched_barrier(0);
    }
    float mx = sink2;
#pragma unroll
    for (int t = 0; t < 5; ++t)
        {   float bv[16];
#pragma unroll
            for (int r = 0; r < 16; ++r) bv[r] = tb[(d0 - 32 * t - crow(r, hi)) & 127];
            asm volatile("" : "+v"(bv[0]), "+v"(bv[1]), "+v"(bv[2]), "+v"(bv[3]), "+v"(bv[4]), "+v"(bv[5]), "+v"(bv[6]), "+v"(bv[7]), "+v"(bv[8]), "+v"(bv[9]), "+v"(bv[10]), "+v"(bv[11]), "+v"(bv[12]), "+v"(bv[13]), "+v"(bv[14]), "+v"(bv[15]));
            if (t >= 1 && t <= 3 && jmin <= 32) {
#pragma unroll
                for (int r = 0; r < 16; ++r) { const float s = st[t][r] + bv[r]; st[t][r] = s; mx = fmaxf(mx, s); }
            } else {
#pragma unroll
            for (int r = 0; r < 16; ++r) { const int jj = 32 * t + crow(r, hi); const int dist = d0 - jj; const bool ok = ((unsigned)dist < 128u) && (jj >= jmin);
                const float s = ok ? st[t][r] + bv[r] : -__builtin_inff(); st[t][r] = s; mx = fmaxf(mx, s); } } }
    mx = fmaxf(mx, __shfl_xor(mx, 32));
    float l = 0.f;
#pragma unroll
    for (int t = 0; t < 5; ++t)
#pragma unroll
        for (int r = 0; r < 16; ++r) { const float p = __builtin_amdgcn_exp2f(st[t][r] - mx); st[t][r] = p; l += p; }
    l += __shfl_xor(l, 32); l += __builtin_amdgcn_exp2f(sink2 - mx);
    const float inv = 1.0f / l;
    f32x16 ot[ND];
#pragma unroll
    for (int d = 0; d < ND; ++d) for (int i = 0; i < 16; ++i) ot[d][i] = 0.f;
    const int g4 = lane >> 4, i16 = lane & 15;
    const LAS unsigned char* vp = Vl + (kt0 * 32 + 4 * hi + (i16 >> 2)) * VS + ((g4 & 1) * 16 + (i16 & 3) * 4) * 2;
#pragma unroll
    for (int t = 0; t < 5; ++t)
#pragma unroll
        for (int s2 = 0; s2 < 2; ++s2) { const bf16x8 pf = pack_step(st[t], s2);
            bf16x8 vfr[ND];
#pragma unroll
            for (int d = 0; d < ND; ++d) { const LAS unsigned char* a = vp + (t * 32 + s2 * 16) * VS + (db + d) * 64; vfr[d] = cat4(vtr(a), vtr(a + 8 * VS)); }
#pragma unroll
            for (int d = 0; d < ND; ++d) ot[d] = MFMA32(vfr[d], pf, ot[d]);
            __builtin_amdgcn_sched_barrier(0); }
#pragma unroll
    for (int d = 0; d < ND; ++d)
#pragma unroll
        for (int r4 = 0; r4 < 4; ++r4) { u32x2 w; w.x = cvtpk(ot[d][4 * r4] * inv, ot[d][4 * r4 + 1] * inv); w.y = cvtpk(ot[d][4 * r4 + 2] * inv, ot[d][4 * r4 + 3] * inv);
            *(u32x2*)(outp + 32 * (db + d) + 8 * r4 + 4 * hi) = w; }
}
__device__ __forceinline__ void load_q(const bf16* qp, const float* qnw, int hi, bf16x8 (&qf)[8]) {
    u32x4 qw[8]; float ss = 0.f;
#pragma unroll
    for (int ks = 0; ks < 8; ++ks) { qw[ks] = *(const u32x4*)(qp + 16 * ks); float f[8]; unpack8(qw[ks], f);
#pragma unroll
        for (int i = 0; i < 8; ++i) ss += f[i] * f[i]; }
    ss += __shfl_xor(ss, 32);
    const float sc = (1.0f / sqrtf(ss * (1.0f / 128.0f) + EPS)) * 0.08838834764831845f * LOG2E;
#pragma unroll
    for (int ks = 0; ks < 8; ++ks) { float f[8]; unpack8(qw[ks], f); const f32x4 w0 = *(const f32x4*)(qnw + 16 * ks + 8 * hi), w1 = *(const f32x4*)(qnw + 16 * ks + 8 * hi + 4);
        f[0] *= sc * w0.x; f[1] *= sc * w0.y; f[2] *= sc * w0.z; f[3] *= sc * w0.w; f[4] *= sc * w1.x; f[5] *= sc * w1.y; f[6] *= sc * w1.z; f[7] *= sc * w1.w;
        qf[ks] = __builtin_bit_cast(bf16x8, pack8(f)); }
}
__device__ __forceinline__ float red16(float v) { v += __shfl_xor(v, 1); v += __shfl_xor(v, 2); v += __shfl_xor(v, 4); v += __shfl_xor(v, 8); return v; }

__device__ __forceinline__ void attn_prompt_unit(const Frame& F, const Ptrs& P, int unit) {
    const int kvh = unit & 3, qb = (unit >> 2) & 31, b = unit >> 7, t0 = 64 * qb, rowb = b * SEQ;
    LAS unsigned char* Kl = F.lds + RING_OFF; LAS unsigned char* Vl = Kl + 192 * KS;
    const f32x4 knw0 = *(const f32x4*)(P_k_nw + (F.tid & 15) * 8), knw1 = *(const f32x4*)(P_k_nw + (F.tid & 15) * 8 + 4);
#pragma unroll 1
    for (int hb = 0; hb < 2; ++hb) {
    u32x4 kwv[3], vwv[3];
#pragma unroll
    for (int it = 0; it < 3; ++it) { const int task = F.tid + 512 * (it + 3 * hb), r = task >> 4, ch = task & 15, pos = t0 - 128 + r;
        kwv[it] = (u32x4){0u, 0u, 0u, 0u}; vwv[it] = kwv[it];
        if (pos >= 0) { const bf16* pr = P_PROJ + (size_t)(rowb + pos) * LDP + kvh * 128 + ch * 8; kwv[it] = *(const u32x4*)(pr + C_K); vwv[it] = *(const u32x4*)(pr + C_V); } }
#pragma unroll
    for (int it = 0; it < 3; ++it) {
        const int task = F.tid + 512 * (it + 3 * hb), r = task >> 4, ch = task & 15, pos = t0 - 128 + r;
        const u32x4 vw = vwv[it];
        float kf[8]; unpack8(kwv[it], kf); float ss = 0.f;
#pragma unroll
        for (int i = 0; i < 8; ++i) ss += kf[i] * kf[i];
        ss = red16(ss);
        const float rstd = 1.0f / sqrtf(ss * (1.0f / 128.0f) + EPS);
        kf[0] *= rstd * knw0.x; kf[1] *= rstd * knw0.y; kf[2] *= rstd * knw0.z; kf[3] *= rstd * knw0.w; kf[4] *= rstd * knw1.x; kf[5] *= rstd * knw1.y; kf[6] *= rstd * knw1.z; kf[7] *= rstd * knw1.w;
        *(LAS u32x4*)(Kl + r * KS + ch * 16) = pack8(kf);
        *(LAS u32x4*)(Vl + r * VS + ch * 16) = vw;
        if (t0 >= SEQ - 128 && r >= 128) {
            const size_t o = (((size_t)b * 128 + (pos - (SEQ - 128))) * 4 + kvh) * 128 + ch * 8; float vf[8]; unpack8(vw, vf);
            *(f32x4*)(P_out + O_PK + o) = (f32x4){kf[0], kf[1], kf[2], kf[3]}; *(f32x4*)(P_out + O_PK + o + 4) = (f32x4){kf[4], kf[5], kf[6], kf[7]};
            *(f32x4*)(P_out + O_PV + o) = (f32x4){vf[0], vf[1], vf[2], vf[3]}; *(f32x4*)(P_out + O_PV + o + 4) = (f32x4){vf[4], vf[5], vf[6], vf[7]};
        }
    }
    }
    __builtin_amdgcn_sched_barrier(0);
    const int q = F.lane & 31, hi = F.lane >> 5, g = F.wave >> 1, sub = F.wave & 1, head = kvh * 4 + g;
    const int row = rowb + t0 + 32 * sub + q;
    bf16x8 qf[8]; load_q(P_PROJ + (size_t)row * LDP + C_Q + head * 128 + 8 * hi, P_q_nw, hi, qf);
    LBAR();
    attn_task<4>(Kl, Vl, sub, qf, 128 + q, 128 - t0 - 32 * sub, (const LAS float*)(F.lds + TB_OFF) + head * 128, P_sinks[head] * LOG2E, P_MIX + (size_t)row * DM + 2048 + head * 128, F.lane, 0);
}
__device__ __forceinline__ void attn_sample_unit(const Frame& F, const Ptrs& P, int unit) {
    const int kvh = unit & 3, b = unit >> 2;
    LAS unsigned char* Kl = F.lds + RING_OFF; LAS unsigned char* Vl = Kl + 160 * KS;
    f32x4 ld[5][4];
#pragma unroll
    for (int it = 0; it < 5; ++it) { const int task = F.tid + 512 * it, r = task >> 4, ch = task & 15;
#pragma unroll
        for (int j = 0; j < 4; ++j) ld[it][j] = (f32x4){0.f, 0.f, 0.f, 0.f};
        if (r < 128) { const size_t o = (((size_t)b * 128 + r) * 4 + kvh) * 128 + ch * 8;
            ld[it][0] = *(const f32x4*)(P_st_k + o); ld[it][1] = *(const f32x4*)(P_st_k + o + 4); ld[it][2] = *(const f32x4*)(P_st_v + o); ld[it][3] = *(const f32x4*)(P_st_v + o + 4); }
        else if (r < 136) { const bf16* pr = P_PROJ + (size_t)(MP + b * 8 + (r - 128)) * LDP + kvh * 128 + ch * 8; float kf[8], vf[8]; unpack8(*(const u32x4*)(pr + C_K), kf); unpack8(*(const u32x4*)(pr + C_V), vf);
            ld[it][0] = (f32x4){kf[0], kf[1], kf[2], kf[3]}; ld[it][1] = (f32x4){kf[4], kf[5], kf[6], kf[7]}; ld[it][2] = (f32x4){vf[0], vf[1], vf[2], vf[3]}; ld[it][3] = (f32x4){vf[4], vf[5], vf[6], vf[7]}; } }
    const f32x4 knw0 = *(const f32x4*)(P_k_nw + (F.tid & 15) * 8), knw1 = *(const f32x4*)(P_k_nw + (F.tid & 15) * 8 + 4);
#pragma unroll
    for (int it = 0; it < 5; ++it) {
        const int task = F.tid + 512 * it, r = task >> 4, ch = task & 15;
        f32x4 k0 = ld[it][0], k1 = ld[it][1]; const f32x4 v0 = ld[it][2], v1 = ld[it][3];
        if (r >= 8 && r < 128) { const size_t o2 = (((size_t)b * 128 + (r - 8)) * 4 + kvh) * 128 + ch * 8; *(f32x4*)(P_out + O_SK + o2) = k0; *(f32x4*)(P_out + O_SK + o2 + 4) = k1; *(f32x4*)(P_out + O_SV + o2) = v0; *(f32x4*)(P_out + O_SV + o2 + 4) = v1; }
        float ss = (k0.x * k0.x + k0.y * k0.y) + (k0.z * k0.z + k0.w * k0.w) + (k1.x * k1.x + k1.y * k1.y) + (k1.z * k1.z + k1.w * k1.w);
        ss = red16(ss);
        if (r >= 128 && r < 136) {
            const float rstd = 1.0f / sqrtf(ss * (1.0f / 128.0f) + EPS);
            k0 = k0 * rstd * knw0; k1 = k1 * rstd * knw1;
            const size_t o2 = (((size_t)b * 128 + 120 + (r - 128)) * 4 + kvh) * 128 + ch * 8;
            *(f32x4*)(P_out + O_SK + o2) = k0; *(f32x4*)(P_out + O_SK + o2 + 4) = k1; *(f32x4*)(P_out + O_SV + o2) = v0; *(f32x4*)(P_out + O_SV + o2 + 4) = v1;
        }
        u32x4 kw, vw; kw.x = cvtpk(k0.x, k0.y); kw.y = cvtpk(k0.z, k0.w); kw.z = cvtpk(k1.x, k1.y); kw.w = cvtpk(k1.z, k1.w); vw.x = cvtpk(v0.x, v0.y); vw.y = cvtpk(v0.z, v0.w); vw.z = cvtpk(v1.x, v1.y); vw.w = cvtpk(v1.z, v1.w);
        *(LAS u32x4*)(Kl + r * KS + ch * 16) = kw;
        *(LAS u32x4*)(Vl + r * VS + ch * 16) = vw;
    }
    LBAR();
    if (F.wave == 0) {
        const int q = F.lane & 31, hi = F.lane >> 5, g = q >> 3, i = q & 7, head = kvh * 4 + g, row = MP + b * 8 + i;
        bf16x8 qf[8]; load_q(P_PROJ + (size_t)row * LDP + C_Q + head * 128 + 8 * hi, P_q_nw, hi, qf);
        attn_task<4>(Kl, Vl, 0, qf, 128 + i, 0, (const LAS float*)(F.lds + TB_OFF) + head * 128, P_sinks[head] * LOG2E, P_MIX + (size_t)row * DM + 2048 + head * 128, F.lane, 0);
    }
}

__device__ __forceinline__ void store8f(float* p, const u32x4 w) { float f[8]; unpack8(w, f); *(f32x4*)p = (f32x4){f[0], f[1], f[2], f[3]}; *(f32x4*)(p + 4) = (f32x4){f[4], f[5], f[6], f[7]}; }
__device__ __forceinline__ void p2_conv_pass(const Frame& F, const Ptrs& P) {
    const int ntask = (M / 8) * 512; bf16* XB = (bf16*)(P_ws + WS_XBCC);
    for (int task = F.bid * 512 + F.tid; task < ntask; task += F.G * 512) {
        const int cc = task & 511, rb = task >> 9, ch = cc * 8, r0 = rb * 8;
        float w[5][8];
#pragma unroll
        for (int k = 0; k < 5; ++k) { const float* src = k < 4 ? P_conv_w + k * 4096 + ch : P_conv_b + ch; const f32x4 a = *(const f32x4*)src, c = *(const f32x4*)(src + 4);
            w[k][0] = a.x; w[k][1] = a.y; w[k][2] = a.z; w[k][3] = a.w; w[k][4] = c.x; w[k][5] = c.y; w[k][6] = c.z; w[k][7] = c.w; }
        float xp[11][8];
        const bf16* src = P_PROJ + (size_t)r0 * LDP + C_X + ch;
        u32x4 raw[8];
#pragma unroll
        for (int t = 0; t < 8; ++t) { raw[t] = *(const u32x4*)(src + (size_t)t * LDP); unpack8(raw[t], xp[3 + t]); }
        if (r0 < MP) {
            if ((r0 & (SEQ - 1)) != 0) {
#pragma unroll
                for (int j = 0; j < 3; ++j) unpack8(*(const u32x4*)(src - (size_t)(3 - j) * LDP), xp[j]); }
            else {
#pragma unroll
                for (int j = 0; j < 3; ++j)
#pragma unroll
                    for (int i = 0; i < 8; ++i) xp[j][i] = 0.f; }
            if ((r0 & (SEQ - 1)) == SEQ - 8) {
#pragma unroll
                for (int j = 0; j < 3; ++j) store8f(P_out + O_PCONV + ((size_t)(r0 >> 11) * 3 + j) * 4096 + ch, raw[5 + j]); }
        } else { const int bs = (r0 - MP) >> 3;
#pragma unroll
            for (int j = 0; j < 3; ++j) { const f32x4 a = *(const f32x4*)(P_st_conv + ((size_t)bs * 3 + j) * 4096 + ch), c = *(const f32x4*)(P_st_conv + ((size_t)bs * 3 + j) * 4096 + ch + 4);
                xp[j][0] = a.x; xp[j][1] = a.y; xp[j][2] = a.z; xp[j][3] = a.w; xp[j][4] = c.x; xp[j][5] = c.y; xp[j][6] = c.z; xp[j][7] = c.w; }
#pragma unroll
            for (int j = 0; j < 3; ++j) store8f(P_out + O_SCONV + ((size_t)bs * 3 + j) * 4096 + ch, raw[5 + j]);
        }
#pragma unroll
        for (int t = 0; t < 8; ++t) { float o[8];
#pragma unroll
            for (int i = 0; i < 8; ++i) o[i] = silu_f(w[4][i] + w[0][i] * xp[t][i] + w[1][i] * xp[t + 1][i] + w[2][i] * xp[t + 2][i] + w[3][i] * xp[t + 3][i]);
            *(u32x4*)(XB + (size_t)(r0 + t) * 4096 + ch) = pack8(o); }
    }
}

constexpr int XSTR = 144, BSTR = 272;
constexpr int L_XS = 0, L_XW = 18432, L_BS = 36864, L_CS = 71680, L_HS = 106496, L_ACS = 123904;

__device__ __forceinline__ void ssd_prompt_unit(const Frame& F, const Ptrs& P, int unit) {
    const int h = unit & 31, b = unit >> 5, grp = h >> 2, rowb0 = b * SEQ;
    LAS unsigned char* L = F.lds + RING_OFF;
    LAS float* ACS2 = (LAS float*)(L + L_ACS); LAS float* DTV2 = ACS2 + 256;
    const bf16* XB = (const bf16*)(P_ws + WS_XBCC);
    for (int i = F.tid; i < 64 * BSTR / 4; i += 512) ((LAS unsigned*)(L + L_HS))[i] = 0u;
    f32x16 hacc; for (int i = 0; i < 16; ++i) hacc[i] = 0.f;
    const float Ah = -__expf(P_A_log[h]), Dh = P_Dv[h], dtb = P_dt_bias[h];
    u32x4 rb[4], rc[4], rx[2]; u32x2 zq[4]; unsigned short dr0 = 0, dr1 = 0;
    u32x2 ow[4]; float ossq = 0.f;
#pragma unroll
    for (int i = 0; i < 4; ++i) ow[i] = (u32x2){0u, 0u};
#define SSD_ISSUE(c) do { int t_ = F.tid; asm volatile("" : "+v"(t_)); \
        const bf16* pB_ = XB + (size_t)(rowb0 + 128 * (c) + (t_ >> 4)) * 4096 + 2048 + grp * 128 + (t_ & 15) * 8; const bf16* pX_ = XB + (size_t)(rowb0 + 128 * (c) + (t_ >> 3)) * 4096 + h * 64 + (t_ & 7) * 8; \
        _Pragma("unroll") for (int j_ = 0; j_ < 4; ++j_) { rb[j_] = *(const u32x4*)(pB_ + (size_t)(32 * j_) * 4096); rc[j_] = *(const u32x4*)(pB_ + (size_t)(32 * j_) * 4096 + 1024); } \
        _Pragma("unroll") for (int j_ = 0; j_ < 2; ++j_) rx[j_] = *(const u32x4*)(pX_ + (size_t)(64 * j_) * 4096); \
        { const int ln_ = t_ & 63; const bf16* zp_ = P_PROJ + (size_t)(rowb0 + 128 * (c) + 32 * (F.wave >> 1) + (ln_ & 31)) * LDP + C_Z + h * 64 + 32 * (F.wave & 1) + 4 * (ln_ >> 5); \
          _Pragma("unroll") for (int r4_ = 0; r4_ < 4; ++r4_) zq[r4_] = *(const u32x2*)(zp_ + 8 * r4_); } \
        if (F.wave == 0) { const bf16* pD_ = P_PROJ + (size_t)(rowb0 + 128 * (c) + 2 * (t_ & 63)) * LDP + C_DT + h; dr0 = pD_[0]; dr1 = pD_[LDP]; } } while (0)
#define SSD_SCAN_STEP(ctrl, rmask, bctl) s_ += __builtin_bit_cast(float, __builtin_amdgcn_update_dpp(0, __builtin_bit_cast(int, s_), ctrl, rmask, 0xf, bctl))
#define SSD_DT(buf) do { if (F.wave == 0) { int ln_ = F.lane; asm volatile("" : "+v"(ln_)); const int ta_ = 2 * ln_; const float dv0_ = softplus_f(bf2f(dr0) + dtb), dv1_ = softplus_f(bf2f(dr1) + dtb); const float a1_ = dv1_ * Ah; float s_ = dv0_ * Ah + a1_; \
        SSD_SCAN_STEP(0x111, 0xf, true); SSD_SCAN_STEP(0x112, 0xf, true); SSD_SCAN_STEP(0x114, 0xf, true); SSD_SCAN_STEP(0x118, 0xf, true); SSD_SCAN_STEP(0x142, 0xa, false); SSD_SCAN_STEP(0x143, 0xc, false); \
        ACS2[(buf) * 128 + ta_] = s_ - a1_; ACS2[(buf) * 128 + ta_ + 1] = s_; DTV2[(buf) * 128 + ta_] = dv0_; DTV2[(buf) * 128 + ta_ + 1] = dv1_; } } while (0)
    SSD_ISSUE(0);
    SSD_DT(0);
    LBAR();
    for (int c = 0; c < 16; ++c) {
        const int rowb = rowb0 + 128 * c; const LAS float* ACS = ACS2 + (c & 1) * 128; const LAS float* DTV = DTV2 + (c & 1) * 128;
        const float acs_end = ACS[127];
        if (c == 8) STAMP(30);
        {
            int t_ = F.tid; asm volatile("" : "+v"(t_)); const int bcc = t_ & 15, br = t_ >> 4, xcc = t_ & 7, xr = t_ >> 3;
#pragma unroll
            for (int j = 0; j < 4; ++j) { *(LAS u32x4*)(L + L_BS + (br + 32 * j) * BSTR + bcc * 16) = rb[j]; *(LAS u32x4*)(L + L_CS + (br + 32 * j) * BSTR + bcc * 16) = rc[j]; }
#pragma unroll
            for (int j = 0; j < 2; ++j) { const int l = xr + 64 * j; *(LAS u32x4*)(L + L_XS + l * XSTR + xcc * 16) = rx[j];
                const float sc = DTV[l] * __expf(acs_end - ACS[l]); float f[8]; unpack8(rx[j], f);
#pragma unroll
                for (int i = 0; i < 8; ++i) f[i] *= sc;
                *(LAS u32x4*)(L + L_XW + l * XSTR + xcc * 16) = pack8(f); }
        }
        __builtin_amdgcn_sched_barrier(0);
        int ln = F.lane; asm volatile("" : "+v"(ln)); const int q = ln & 31, hi = ln >> 5, g4 = ln >> 4, i16 = ln & 15;
        const int pt = F.wave & 1, lt = F.wave >> 1, l = 32 * lt + q, row = rowb + l;
        u32x2 zw[4];
#pragma unroll
        for (int r4 = 0; r4 < 4; ++r4) zw[r4] = zq[r4];
        if (c > 0) { const int prow_ = row - 128;
#pragma unroll
            for (int r4 = 0; r4 < 4; ++r4) *(u32x2*)(P_MIX + (size_t)prow_ * DM + h * 64 + 32 * pt + 8 * r4 + 4 * hi) = ow[r4];
            if (hi == 0) atomicAdd(P_ssq + SSQ_REP_OFF + prow_, ossq); }
        if (c < 15) SSD_ISSUE(c + 1);
        LBAR();
        if (c == 8) STAMP(31);
        {
            bf16x8 cf[8];
#pragma unroll
            for (int ks = 0; ks < 8; ++ks) cf[ks] = *(const LAS bf16x8*)(L + L_CS + l * BSTR + ks * 32 + hi * 16);
            f32x16 y; for (int i = 0; i < 16; ++i) y[i] = 0.f;
            if (c > 0) {
                bf16x8 hfr[8];
#pragma unroll
                for (int ks = 0; ks < 8; ++ks) hfr[ks] = *(const LAS bf16x8*)(L + L_HS + (32 * pt + q) * BSTR + ks * 32 + hi * 16);
#pragma unroll
                for (int ks = 0; ks < 8; ++ks) y = MFMA32(hfr[ks], cf[ks], y);
            }
            const float acs_l = ACS[l], ea = __expf(acs_l);
#pragma unroll
            for (int i = 0; i < 16; ++i) y[i] *= ea;
#pragma unroll 1
            for (int st = 0; st <= lt; ++st) {
                f32x16 g; for (int i = 0; i < 16; ++i) g[i] = 0.f;
                bf16x8 bfr[8], xfr[2];
#pragma unroll
                for (int ks = 0; ks < 8; ++ks) bfr[ks] = *(const LAS bf16x8*)(L + L_BS + (32 * st + q) * BSTR + ks * 32 + hi * 16);
#pragma unroll
                for (int s2 = 0; s2 < 2; ++s2) { const LAS unsigned char* a = L + L_XS + (32 * st + 16 * s2 + 4 * hi + (i16 >> 2)) * XSTR + (32 * pt + (g4 & 1) * 16 + (i16 & 3) * 4) * 2; xfr[s2] = cat4(vtr(a), vtr(a + 8 * XSTR)); }
#pragma unroll
                for (int ks = 0; ks < 8; ++ks) g = MFMA32(bfr[ks], cf[ks], g);
#pragma unroll
                for (int r4 = 0; r4 < 4; ++r4) {
                    const f32x4 a4 = *(const LAS f32x4*)(ACS + 32 * st + 8 * r4 + 4 * hi), d4 = *(const LAS f32x4*)(DTV + 32 * st + 8 * r4 + 4 * hi);
#pragma unroll
                    for (int e = 0; e < 4; ++e) { const int s = 32 * st + 8 * r4 + 4 * hi + e; const float v = g[4 * r4 + e] * __expf(fminf(acs_l - a4[e], 0.f)) * d4[e]; g[4 * r4 + e] = (s <= l) ? v : 0.f; } }
#pragma unroll
                for (int s2 = 0; s2 < 2; ++s2) { const bf16x8 pf = pack_step(g, s2); y = MFMA32(xfr[s2], pf, y); }
                __builtin_amdgcn_sched_barrier(0);
            }
            float ssq = 0.f;
#pragma unroll
            for (int r4 = 0; r4 < 4; ++r4) { const u32x2 xw = *(const LAS u32x2*)(L + L_XS + l * XSTR + (32 * pt + 8 * r4 + 4 * hi) * 2);
                const f32x4 nw = *(const f32x4*)(P_ssd_nw + h * 64 + 32 * pt + 8 * r4 + 4 * hi);
                const float z0 = bflo(zw[r4].x), z1 = bfhi(zw[r4].x), z2 = bflo(zw[r4].y), z3 = bfhi(zw[r4].y);
                const float g0 = (y[4 * r4] + Dh * bflo(xw.x)) * silu_f(z0), g1 = (y[4 * r4 + 1] + Dh * bfhi(xw.x)) * silu_f(z1), g2 = (y[4 * r4 + 2] + Dh * bflo(xw.y)) * silu_f(z2), g3 = (y[4 * r4 + 3] + Dh * bfhi(xw.y)) * silu_f(z3);
                ssq += (g0 * g0 + g1 * g1) + (g2 * g2 + g3 * g3);
                ow[r4].x = cvtpk(g0 * nw.x, g1 * nw.y); ow[r4].y = cvtpk(g2 * nw.z, g3 * nw.w); }
            ssq += __shfl_xor(ssq, 32);
            ossq = ssq;
        }
        if (c == 8) STAMP(34);
        LBAR();
        if (c == 8) STAMP(32);
        {
            const int pt2 = F.wave & 1, nt = F.wave >> 1; const float eend = __expf(acs_end);
#pragma unroll
            for (int i = 0; i < 16; ++i) hacc[i] *= eend;
#pragma unroll
            for (int kb = 0; kb < 2; ++kb) { bf16x8 afr[4], bfr[4];
#pragma unroll
                for (int k4 = 0; k4 < 4; ++k4) { const int ks = 4 * kb + k4, srow = 16 * ks + 8 * hi + (i16 >> 2), cofs = ((g4 & 1) * 16 + (i16 & 3) * 4) * 2;
                    const LAS unsigned char* a = L + L_XW + srow * XSTR + 64 * pt2 + cofs; const LAS unsigned char* bp = L + L_BS + srow * BSTR + 64 * nt + cofs;
                    afr[k4] = cat4(vtr(a), vtr(a + 4 * XSTR)); bfr[k4] = cat4(vtr(bp), vtr(bp + 4 * BSTR)); }
#pragma unroll
                for (int k4 = 0; k4 < 4; ++k4) hacc = MFMA32(afr[k4], bfr[k4], hacc); }
#pragma unroll
            for (int r = 0; r < 16; ++r) *(LAS unsigned short*)(L + L_HS + (32 * pt2 + crow(r, hi)) * BSTR + (32 * nt + q) * 2) = (unsigned short)(cvtpk(hacc[r], 0.f) & 0xffffu);
            if (c < 15) SSD_DT((c + 1) & 1);
        }
        LBAR();
        if (c == 8) STAMP(33);
    }
#undef SSD_ISSUE
#undef SSD_DT
#undef SSD_SCAN_STEP
    {   const int ln = F.lane, q = ln & 31, hi = ln >> 5, pt = F.wave & 1, lt = F.wave >> 1, prow_ = rowb0 + 128 * 15 + 32 * lt + q;
#pragma unroll
        for (int r4 = 0; r4 < 4; ++r4) *(u32x2*)(P_MIX + (size_t)prow_ * DM + h * 64 + 32 * pt + 8 * r4 + 4 * hi) = ow[r4];
        if (hi == 0) atomicAdd(P_ssq + SSQ_REP_OFF + prow_, ossq); }
    {   const int pt = F.wave & 1, nt = F.wave >> 1, q = F.lane & 31, hi = F.lane >> 5;
#pragma unroll
        for (int r = 0; r < 16; ++r) P_out[O_PSSM + ((size_t)(b * 32 + h) * 64 + 32 * pt + crow(r, hi)) * 128 + 32 * nt + q] = hacc[r]; }
}

__device__ __forceinline__ void ssd_sample_unit(const Frame& F, const Ptrs& P, int unit) {
    const int grp = unit & 7, b = unit >> 3;
    STAMP(40);
    LAS float* XC = (LAS float*)(F.lds + RING_OFF); LAS float* BC = XC + 2048; LAS float* CC = BC + 1024; LAS float* ZC = CC + 1024; LAS float* DTVs = ZC + 2048; LAS float* ACSs = DTVs + 32;
    LAS float* SQL = ACSs + 32; LAS float* CBm = SQL + 32; LAS float* Gm = CBm + 64; LAS float* Wm = Gm + 256; LAS float* Em = Wm + 32;
    const int hh = F.wave >> 1, half = F.wave & 1, h = grp * 4 + hh, pl = F.lane & 31, hi = F.lane >> 5, p = 32 * half + pl;
    const size_t sofs = ((size_t)(b * 32 + h) * 64 + p) * 128 + 8 * hi;
    f32x4 hk[8][2];
#pragma unroll
    for (int ks = 0; ks < 8; ++ks) { hk[ks][0] = *(const f32x4*)(P_st_ssm + sofs + 16 * ks); hk[ks][1] = *(const f32x4*)(P_st_ssm + sofs + 16 * ks + 4); }
    if (F.tid < 8) SQL[F.tid] = 0.f;
    {   const int ci = F.tid; int ch, stride; LAS float* dst; const bf16* XB = (const bf16*)(P_ws + WS_XBCC);
        if (ci < 256) { ch = grp * 256 + ci; dst = XC + ci; stride = 256; } else if (ci < 384) { ch = 2048 + grp * 128 + (ci - 256); dst = BC + (ci - 256); stride = 128; } else { ch = 3072 + grp * 128 + (ci - 384); dst = CC + (ci - 384); stride = 128; }
#pragma unroll
        for (int t = 0; t < 8; ++t) dst[t * stride] = bf2f(XB[(size_t)(MP + b * 8 + t) * 4096 + ch]);
        if (ci < 256) {
#pragma unroll
            for (int t = 0; t < 8; ++t) ZC[t * 256 + ci] = bf2f(P_PROJ[(size_t)(MP + b * 8 + t) * LDP + C_Z + grp * 256 + ci]); }
    }
    if (F.tid < 32) { const int t = F.tid & 7, h2 = grp * 4 + (F.tid >> 3); DTVs[F.tid] = softplus_f(bf2f(P_PROJ[(size_t)(MP + b * 8 + t) * LDP + C_DT + h2]) + P_dt_bias[h2]); }
    LBAR();
    if (F.tid < 32) { const int t = F.tid & 7, h2 = grp * 4 + (F.tid >> 3); const float Ah = -__expf(P_A_log[h2]); float s = 0.f;
        for (int k = 0; k < 8; ++k) s += (k <= t) ? DTVs[(F.tid & ~7) + k] * Ah : 0.f;
        ACSs[F.tid] = s; }
    else if (F.wave == 1) {
        const int l = F.lane & 31, hq = F.lane >> 5, tr = l & 7; const float am = (l < 8) ? 1.0f : 0.0f;
        f32x16 cb; for (int i = 0; i < 16; ++i) cb[i] = 0.f;
#pragma unroll
        for (int ks = 0; ks < 8; ++ks) { const f32x4 c0 = *(const LAS f32x4*)(CC + tr * 128 + 16 * ks + 8 * hq) * am, c1 = *(const LAS f32x4*)(CC + tr * 128 + 16 * ks + 8 * hq + 4) * am;
            const f32x4 b0 = *(const LAS f32x4*)(BC + tr * 128 + 16 * ks + 8 * hq) * am, b1 = *(const LAS f32x4*)(BC + tr * 128 + 16 * ks + 8 * hq + 4) * am;
            u32x4 aw, bw; aw.x = cvtpk(c0.x, c0.y); aw.y = cvtpk(c0.z, c0.w); aw.z = cvtpk(c1.x, c1.y); aw.w = cvtpk(c1.z, c1.w); bw.x = cvtpk(b0.x, b0.y); bw.y = cvtpk(b0.z, b0.w); bw.z = cvtpk(b1.x, b1.y); bw.w = cvtpk(b1.z, b1.w);
            cb = MFMA32(__builtin_bit_cast(bf16x8, aw), __builtin_bit_cast(bf16x8, bw), cb); }
        if (l < 8) {
#pragma unroll
            for (int r = 0; r < 4; ++r) CBm[(4 * hq + r) * 8 + l] = cb[r]; } }
    LBAR();
    if (F.tid < 256) { const int h3 = F.tid >> 6, t = (F.tid >> 3) & 7, s2 = F.tid & 7;
        const float at = ACSs[h3 * 8 + t], as = ACSs[h3 * 8 + s2];
        Gm[F.tid] = (s2 <= t) ? CBm[t * 8 + s2] * __expf(at - as) * DTVs[h3 * 8 + s2] : 0.f;
        if (t == 7) Wm[h3 * 8 + s2] = __expf(at - as) * DTVs[h3 * 8 + s2];
        if (s2 == 0) Em[h3 * 8 + t] = __expf(at); }
    LBAR();
    STAMP(41);
    f32x16 yacc; for (int i = 0; i < 16; ++i) yacc[i] = 0.f;
    {   const int tr = pl & 7; const float am = (pl < 8) ? 1.0f : 0.0f;
#pragma unroll
        for (int ks = 0; ks < 8; ++ks) { const f32x4 c0 = *(const LAS f32x4*)(CC + tr * 128 + 16 * ks + 8 * hi) * am, c1 = *(const LAS f32x4*)(CC + tr * 128 + 16 * ks + 8 * hi + 4) * am;
            u32x4 aw, bw; aw.x = cvtpk(c0.x, c0.y); aw.y = cvtpk(c0.z, c0.w); aw.z = cvtpk(c1.x, c1.y); aw.w = cvtpk(c1.z, c1.w);
            bw.x = cvtpk(hk[ks][0].x, hk[ks][0].y); bw.y = cvtpk(hk[ks][0].z, hk[ks][0].w); bw.z = cvtpk(hk[ks][1].x, hk[ks][1].y); bw.w = cvtpk(hk[ks][1].z, hk[ks][1].w);
            yacc = MFMA32(__builtin_bit_cast(bf16x8, aw), __builtin_bit_cast(bf16x8, bw), yacc); } }
    float xs[8];
#pragma unroll
    for (int s2 = 0; s2 < 8; ++s2) xs[s2] = XC[s2 * 256 + hh * 64 + p];
    const float Dh = P_Dv[h], nw = P_ssd_nw[h * 64 + p];
    float sq[4];
#pragma unroll
    for (int r = 0; r < 4; ++r) { const int t = 4 * hi + r; float y = Em[hh * 8 + t] * yacc[r];
        const f32x4 g0 = *(const LAS f32x4*)(Gm + hh * 64 + t * 8), g1 = *(const LAS f32x4*)(Gm + hh * 64 + t * 8 + 4);
        y += (g0.x * xs[0] + g0.y * xs[1]) + (g0.z * xs[2] + g0.w * xs[3]) + (g1.x * xs[4] + g1.y * xs[5]) + (g1.z * xs[6] + g1.w * xs[7]);
        const float xt = hi ? xs[4 + r] : xs[r];
        const float yg = (y + Dh * xt) * silu_f(ZC[t * 256 + hh * 64 + p]);
        sq[r] = yg * yg;
        P_MIX[(size_t)(MP + b * 8 + t) * DM + h * 64 + p] = (bf16)(cvtpk(yg * nw, 0.f) & 0xffffu); }
#pragma unroll
    for (int o = 1; o < 32; o <<= 1) {
#pragma unroll
        for (int r = 0; r < 4; ++r) sq[r] += __shfl_xor(sq[r], o); }
    if (pl == 0) {
#pragma unroll
        for (int r = 0; r < 4; ++r) atomicAdd((float*)(SQL + 4 * hi + r), sq[r]); }
    {   const float e7 = Em[hh * 8 + 7]; float wx[8];
#pragma unroll
        for (int s2 = 0; s2 < 8; ++s2) wx[s2] = Wm[hh * 8 + s2] * xs[s2];
#pragma unroll
        for (int ks = 0; ks < 8; ++ks)
#pragma unroll
            for (int j = 0; j < 2; ++j) { f32x4 a = hk[ks][j] * e7;
#pragma unroll
                for (int s2 = 0; s2 < 8; ++s2) a += *(const LAS f32x4*)(BC + s2 * 128 + 16 * ks + 8 * hi + 4 * j) * wx[s2];
                *(f32x4*)(P_out + O_SSSM + sofs + 16 * ks + 4 * j) = a; } }
    STAMP(42);
    LBAR();
    if (F.tid < 8) atomicAdd(P_ssq + SSQ_REP_OFF + MP + b * 8 + F.tid, SQL[F.tid]);
}

#define WQ_LOOP(FR, ctr, N, CALL) do { unsigned nx_ = 0u; LBAR(); if ((FR).tid == 0) *slot = __hip_atomic_fetch_add((ctr), 1u, RLX_AGENT); LBAR(); \
        for (;;) { const int u = (int)*slot; if (u >= (int)(N)) break; if ((FR).tid == 0) nx_ = __hip_atomic_fetch_add((ctr), 1u, RLX_AGENT); \
            CALL; LBAR(); if ((FR).tid == 0) *slot = nx_; LBAR(); } } while (0)
__device__ __forceinline__ void p2_mixer(const Frame& F, const Ptrs& P, volatile LAS unsigned* slot, int rep) {
    {
        LAS float* TB = (LAS float*)(F.lds + TB_OFF);
        for (int i = F.tid; i < 16 * 128; i += 512) { const int hd = i >> 7, dist = i & 127; TB[i] = P_rel_bias[t5_bucket(dist) * 16 + hd] * LOG2E; }
    }
#ifndef MIX_MASK
#define MIX_MASK 15
#endif
    if (MIX_MASK & 1) for (;;) { const int u = wq_next(P_ctl + CW_Q + (0 + 4 * rep) * 64, slot, F.tid); if (u >= 128 * MIXDUP_A) break; ssd_prompt_unit(F, P, u / MIXDUP_A); } STAMP(20);
    if (MIX_MASK & 2) { WQ_LOOP(F, P_ctl + CW_Q + (1 + 4 * rep) * 64, 512 * MIXDUP_B, attn_prompt_unit(F, P, u / MIXDUP_B)); } STAMP(21);
    if (MIX_MASK & 4) { WQ_LOOP(F, P_ctl + CW_Q + (2 + 4 * rep) * 64, 512 * MIXDUP_C, attn_sample_unit(F, P, u / MIXDUP_C)); } STAMP(22);
    if (MIX_MASK & 8) { Frame F2 = F; asm volatile("" : "+v"(F2.tid), "+v"(F2.lane));
        WQ_LOOP(F2, P_ctl + CW_Q + (3 + 4 * rep) * 64, 1024 * MIXDUP_D, ssd_sample_unit(F2, P, u / MIXDUP_D)); } STAMP(23);
}

__device__ __forceinline__ void p3_ssd_norm(const Frame& F, const Ptrs& P) {
    const int gw = F.bid * NWAVES + F.wave, NGW = F.G * NWAVES;
    for (int m = gw; m < M; m += NGW) { const float rstd = 1.0f / sqrtf(P_ssq[m] * (1.0f / (2048.0f * (m < MP ? MIXDUP_A : MIXDUP_D))) + EPS); u32x4* mp = (u32x4*)(P_MIX + (size_t)m * DM + 2048) + F.lane;
#pragma unroll
        for (int j = 0; j < 4; ++j) { float f[8]; unpack8(mp[64 * j], f);
#pragma unroll
            for (int i = 0; i < 8; ++i) f[i] *= rstd;
            mp[64 * j] = pack8(f); } }
}
__device__ __forceinline__ size_t slab_off(int rs, int c, int kp) { return ((size_t)(((rs >> 8) * 16 + (c >> 8)) * 4 + kp)) * 65536 + (size_t)(rs & 255) * 256 + (c & 255); }
__device__ __forceinline__ void p5_sample_rows(const Frame& F, const Ptrs& P) {
    const int gw = F.bid * NWAVES + F.wave, NGW = F.G * NWAVES; const float* slab = (const float*)(P_ws + WS_SLAB);
    for (int rs = gw; rs < MS; rs += NGW) { float ss = 0.f; u32x2* o8 = (u32x2*)(P_X1B + (size_t)(MP + rs) * DM) + F.lane;
#pragma unroll 4
        for (int j = 0; j < 16; ++j) { const int c = 4 * (F.lane + 64 * j); f32x4 v = *(const f32x4*)(P_x_sample + (size_t)rs * DM + c);
#pragma unroll
            for (int kp = 0; kp < 4; ++kp) v += *(const f32x4*)(slab + slab_off(rs, c, kp));
            ss += (v.x * v.x + v.y * v.y) + (v.z * v.z + v.w * v.w);
            u32x2 o; o.x = cvtpk(v.x, v.y); o.y = cvtpk(v.z, v.w); o8[64 * j] = o; }
        ss = wave_sum(ss);
        if (F.lane == 0) P_ssq2[MP + rs] = ss;
    }
}
__device__ __forceinline__ void p9_final_reduce(const Frame& F, const Ptrs& P) {
    const int gw = F.bid * NWAVES + F.wave, NGW = F.G * NWAVES; const float* slab = (const float*)(P_ws + WS_SLAB);
    for (int rs = gw; rs < MS; rs += NGW) { const u32x2* x8 = (const u32x2*)(P_X1B + (size_t)(MP + rs) * DM) + F.lane;
#pragma unroll 4
        for (int j = 0; j < 16; ++j) { const int c = 4 * (F.lane + 64 * j); const u32x2 xw = x8[64 * j]; f32x4 v = (f32x4){bflo(xw.x), bfhi(xw.x), bflo(xw.y), bfhi(xw.y)};
#pragma unroll
            for (int kp = 0; kp < 4; ++kp) v += *(const f32x4*)(slab + slab_off(rs, c, kp));
            *(f32x4*)(P_out + (size_t)(MP + rs) * DM + c) = v; }
    }
}
__device__ __forceinline__ void p7_fix(const Frame& F, const Ptrs& P) {
    constexpr int NC4 = DFF / 4; const int ntask = 28 * NC4; const float* fix = (const float*)(P_ws + WS_FIX);
    for (int task = F.bid * 512 + F.tid; task < ntask; task += F.G * 512) {
        const int cc = task % NC4, pi = task / NC4, pm = 8 * (pi / 7) + 1 + (pi % 7), j = 4 * cc;
        const f32x4 h0 = *(const f32x4*)(fix + ((size_t)(pm - 1) * 2 + 0) * DFF + j), h1 = *(const f32x4*)(fix + ((size_t)(pm - 1) * 2 + 1) * DFF + j);
        const f32x4 g0 = *(const f32x4*)(fix + ((size_t)(72 + pm * 2 + 0)) * DFF + j), g1 = *(const f32x4*)(fix + ((size_t)(72 + pm * 2 + 1)) * DFF + j);
        const f32x4 u0 = *(const f32x4*)(fix + ((size_t)(144 + pm * 2 + 0)) * DFF + j), u1 = *(const f32x4*)(fix + ((size_t)(144 + pm * 2 + 1)) * DFF + j);
        const f32x4 w0 = *(const f32x4*)(P_fconv_w + j), w1 = *(const f32x4*)(P_fconv_w + DFF + j), w2 = *(const f32x4*)(P_fconv_w + 2 * DFF + j), bb = *(const f32x4*)(P_fconv_b + j);
        const f32x4 c0 = bb + w0 * h0 + w1 * h1 + w2 * g0, c1 = bb + w0 * h1 + w1 * g0 + w2 * g1;
        u32x2 a0, a1;
        a0.x = cvtpk(silu_f(c0.x) * u0.x, silu_f(c0.y) * u0.y); a0.y = cvtpk(silu_f(c0.z) * u0.z, silu_f(c0.w) * u0.w);
        a1.x = cvtpk(silu_f(c1.x) * u1.x, silu_f(c1.y) * u1.y); a1.y = cvtpk(silu_f(c1.z) * u1.z, silu_f(c1.w) * u1.w);
        *(u32x2*)(P_ACT + pg8::act_off(256 * pm, j)) = a0; *(u32x2*)(P_ACT + pg8::act_off(256 * pm + 1, j)) = a1;
    }
}

constexpr int TAIL_NT = 24;
__device__ __forceinline__ void p8_tail_reduce(const Frame& F, const Ptrs& P) {
    const float* slab = (const float*)(P_ws + WS_SLAB); const int ntask = TAIL_NT * 32 * 4; const int gw = F.bid * NWAVES + F.wave, NGW = F.G * NWAVES;
    for (int task = gw; task < ntask; task += NGW) {
        const int c8 = task & 3, sq = (task >> 2) & 31, t = task >> 7, tt = F.lane >> 3, cq = c8 * 8 + (F.lane & 7);
        const int j = (80 + (t >> 2)) * 128 + 4 * cq, r = (32 + (t & 3)) * 256 + 8 * sq + tt, bs = (r - MP) >> 3;
        const float* sp = slab + (size_t)(t * 8) * 65536 + (size_t)(8 * sq + tt) * 256 + 4 * cq;
        f32x4 g = (f32x4){0.f, 0.f, 0.f, 0.f}, uu = g;
#pragma unroll
        for (int kp = 0; kp < 8; ++kp) { g += *(const f32x4*)(sp + (size_t)kp * 65536); uu += *(const f32x4*)(sp + (size_t)kp * 65536 + 128); }
        const float rs = 1.0f / sqrtf(P_ssq2[r] * (1.0f / DM) + EPS); g *= rs; uu *= rs;
        const f32x4 w0 = *(const f32x4*)(P_fconv_w + j), w1 = *(const f32x4*)(P_fconv_w + DFF + j), w2 = *(const f32x4*)(P_fconv_w + 2 * DFF + j), bb = *(const f32x4*)(P_fconv_b + j);
        const f32x4 s0 = *(const f32x4*)(P_st_ffn + ((size_t)bs * 2 + 0) * DFF + j), s1 = *(const f32x4*)(P_st_ffn + ((size_t)bs * 2 + 1) * DFF + j);
        f32x4 p1, p2;
#pragma unroll
        for (int e = 0; e < 4; ++e) { const float a1 = __shfl_up(g[e], 8), a2 = __shfl_up(g[e], 16); p1[e] = (tt >= 1) ? a1 : s1[e]; p2[e] = (tt >= 2) ? a2 : (tt == 1 ? s1[e] : s0[e]); }
        const f32x4 gc = bb + w0 * p2 + w1 * p1 + w2 * g;
        u32x2 a; a.x = cvtpk(silu_f(gc.x) * uu.x, silu_f(gc.y) * uu.y); a.y = cvtpk(silu_f(gc.z) * uu.z, silu_f(gc.w) * uu.w);
        *(u32x2*)(P_ACT + pg8::act_off(r, j)) = a;
        if (tt >= 6) *(f32x4*)(P_out + O_SFFN + ((size_t)bs * 2 + (tt - 6)) * DFF + j) = g;
    }
}

__global__ void __launch_bounds__(NWAVES * 64, 2) hymba_fwd(Args args) {
    extern __shared__ __attribute__((aligned(16))) unsigned char lds_raw[];
    Frame F; F.lds = (LAS unsigned char*)lds_raw; F.tid = threadIdx.x; F.lane = F.tid & 63; F.wave = __builtin_amdgcn_readfirstlane(F.tid >> 6); F.G = KARG->grid; F.bid = blockIdx.x;
    volatile LAS unsigned* MISC = (volatile LAS unsigned*)(F.lds + MISC_OFF);
    Ptrs P;
    for (int u = F.tid; u < (LDS_BYTES - LDSCTL_OFF) / 4; u += NWAVES * 64) ((LAS unsigned*)(F.lds + LDSCTL_OFF))[u] = 0u;
    __syncthreads();
    if (N_LAUNCHES == 1) (void)xcd_barrier_post((unsigned*)(P_ctl + CW_BAR), MISC + 8);
    const int lo = KARG->ph_lo, hi = KARG->ph_hi;
    STAMP(0);
#ifndef PHASE_MASK
#define PHASE_MASK 0x7ff
#endif
#define IN(k) ((((PHASE_MASK) >> (k)) & 1) && lo <= (k) && (k) < hi)
#define SEAM(k) do { if (IN(k) && IN((k) + 1)) { XcdBarrier b_; b_.bar = (unsigned*)(P_ctl + CW_BAR); b_.x = xb_xcc_id(); b_.st = MISC + 8; xcd_barrier(b_); } } while (0)

    if (IN(0)) { for (int rep = 0; rep < NREP_P0; ++rep) p0_prologue(F, P); } SEAM(0); STAMP(1);
    if (IN(1)) {
        pg8::Gemm g{P_XN, P_W1, M, LDP, DM}; pg8::Gemm1BlockOrder S{F.G, F.bid, DM / 64};
        pg8::EpiStoreBf16 E{P_PROJ, LDP};
        pg8::gemm_phase<pg8::EpiStoreBf16, pg8::Gemm1BlockOrder, PG8_ALIGN, PG8_SP2>(F.lds + RING_OFF, g, S, E);
        convert_weights_dyn<3>(F, P_ctl + CW_Q + 9 * 64);
    } SEAM(1); STAMP(2);
    if (IN(2)) { p2_conv_pass(F, P); } SEAM(2); STAMP(3);
    if (IN(3)) { for (int rep = NREP_MIX - 1; rep >= 0; --rep) { if (F.tid == 0) MISC[5] = (unsigned)(rep * M); __syncthreads(); p2_mixer(F, P, MISC + 4, rep); } } SEAM(3); STAMP(4);
    if (IN(5)) {
        pg8::Gemm g{P_MIX, P_W2, M, DM, DM};
        { pg8::ChainOrder S; S.S0.init(MP, DM, F.G, F.bid, DM); S.ntA = 32; S.ntB = 32; pg8::EpiResBf16Ssq E{P_x_prompt, P_X1B, P_ssq2, DM, P_ssq};
          pg8::gemm_phase<pg8::EpiResBf16Ssq, pg8::ChainOrder, PG8_ALIGN, PG8_SP2>(F.lds + RING_OFF, g, S, E); }
        { pg8::PieceOrder S{F.G, F.bid, MP / 256, DM / 256, 4 * (MS / 256) * (DM / 256), 16, 16}; pg8::EpiSlab E{(float*)(P_ws + WS_SLAB), P_ssq, 32};
          pg8::gemm_phase<pg8::EpiSlab, pg8::PieceOrder, PG8_ALIGN, PG8_SP2>(F.lds + RING_OFF, g, S, E); }
    } SEAM(5); STAMP(6);
    if (IN(6)) { p5_sample_rows(F, P); } SEAM(6); STAMP(7);
    if (IN(7)) {
        pg8::Gemm g{P_X1B, P_W3, M, NGU, DM};
        pg8::EpiGateUp E{P_ACT, P_fconv_w, P_fconv_b, P_st_ffn, (float*)(P_ws + WS_FIX), P_out, (LAS float*)(F.lds + CWL_OFF), P_ssq2};
        { pg8::Gemm3BlockOrder S{F.G, F.bid, DM / 64};
          pg8::gemm_phase<pg8::EpiGateUp, pg8::Gemm3BlockOrder, true, PG8_SP2>(F.lds + RING_OFF, g, S, E); }
        { pg8::TailPieceOrder S{F.G, F.bid, TAIL_NT * 8}; pg8::EpiSlabPerm E2{(float*)(P_ws + WS_SLAB)};
          STAMP(50);
          pg8::gemm_phase<pg8::EpiSlabPerm, pg8::TailPieceOrder, PG8_ALIGN, PG8_SP2>(F.lds + RING_OFF, g, S, E2); }
        STAMP(51);
        convert_weights_dyn<4>(F, P_ctl + CW_Q + 10 * 64);
    } SEAM(7); STAMP(8);
    if (IN(8)) { p7_fix(F, P); p8_tail_reduce(F, P); } SEAM(8); STAMP(9);
    if (IN(9)) {
        pg8::Gemm g{P_ACT, P_W4, M, DM, DFF};
        { pg8::HalfMOrder S{F.G, F.bid, DFF / 64}; pg8::EpiResFromBf16 E{P_X1B, P_out, DM};
          pg8::gemm_phase<pg8::EpiResFromBf16, pg8::HalfMOrder, PG8_ALIGN, PG8_SP2, true>(F.lds + RING_OFF, g, S, E); }
        { pg8::PieceOrder S{F.G, F.bid, MP / 256, DM / 256, 4 * (MS / 256) * (DM / 256), 44, 42}; pg8::EpiSlab E{(float*)(P_ws + WS_SLAB), nullptr, 0};
          pg8::gemm_phase<pg8::EpiSlab, pg8::PieceOrder, PG8_ALIGN, PG8_SP2, true>(F.lds + RING_OFF, g, S, E); }
    } SEAM(9); STAMP(10);
    if (IN(10)) { p9_final_reduce(F, P); }
    STAMP(11);
#ifdef PROBE_A
    if (F.bid == PROBE_BID && F.tid == 0) { volatile LAS unsigned* m_ = (volatile LAS unsigned*)(F.lds + MISC_OFF) + 16; const unsigned long long a_ = ((unsigned long long)m_[1] << 32) | m_[0], b_ = ((unsigned long long)m_[3] << 32) | m_[2];
        const unsigned long long d_ = (b_ - a_) * PROBE_MULT, s0_ = __builtin_amdgcn_s_memrealtime(); while (__builtin_amdgcn_s_memrealtime() - s0_ < d_) __builtin_amdgcn_s_sleep(8); }
#endif
#undef IN
#undef SEAM
}

extern "C" void kernel_launch(void* const* d_in, const int* in_sizes, int n_in, void* d_out, int out_size, void* d_ws, size_t ws_size, hipStream_t stream) {
    static int grid = 0;
    if (grid == 0) {
        if (n_in != 26 || (size_t)out_size != O_END || ws_size < WS_END) { fprintf(stderr, "kernel_launch: unexpected shapes: n_in %d out %d ws %zu (need %zu); nothing launched\n", n_in, out_size, ws_size, (size_t)WS_END); grid = -1; return; }
        int dev = 0, cus = 0, per_cu = 0;
        if (hipGetDevice(&dev) != hipSuccess || hipDeviceGetAttribute(&cus, hipDeviceAttributeMultiprocessorCount, dev) != hipSuccess) { grid = -1; return; }
        if (hipFuncSetAttribute((const void*)hymba_fwd, hipFuncAttributeMaxDynamicSharedMemorySize, LDS_BYTES) != hipSuccess) { fprintf(stderr, "kernel_launch: hipFuncSetAttribute failed\n"); grid = -1; return; }
        if (hipOccupancyMaxActiveBlocksPerMultiprocessor(&per_cu, (const void*)hymba_fwd, NWAVES * 64, LDS_BYTES) != hipSuccess || per_cu < 1) { fprintf(stderr, "kernel_launch: occupancy query reports %d blocks per CU\n", per_cu); }
        (void)hipGetLastError();
        grid = cus;
    }
    if (grid < 0) return;
    if (hipMemsetAsync((char*)d_ws + WS_CTL, 0, CTL_ZERO_BYTES, stream) != hipSuccess) return;
    Args a{};
    for (int i = 0; i < 26; ++i) a.in[i] = (const float*)d_in[i];
    a.out = (float*)d_out; a.ws = (unsigned char*)d_ws; a.grid = grid; a.pad = 0;
    if (N_LAUNCHES == 1) { a.ph_lo = 0; a.ph_hi = N_PHASES; hipLaunchKernelGGL(hymba_fwd, dim3(grid), dim3(NWAVES * 64), LDS_BYTES, stream, a); }
    else { for (int li = 0; li < N_PHASES; ++li) { a.ph_lo = li; a.ph_hi = li + 1; hipLaunchKernelGGL(hymba_fwd, dim3(grid), dim3(NWAVES * 64), LDS_BYTES, stream, a); } }
}
```

```cpp
#include <hip/hip_runtime.h>
#include <cstdio>
#include <cstdint>
namespace pg8 {
#define PG8_LAS __attribute__((address_space(3)))
typedef unsigned short bf16_t;
typedef short bf16x8 __attribute__((ext_vector_type(8)));
typedef float f32x4 __attribute__((ext_vector_type(4)));
typedef unsigned u32x4 __attribute__((ext_vector_type(4)));
constexpr int BM = 256, BK = 64, HALF = 128, HTB = HALF * BK * 2  , STAGE_BYTES = 8 * HTB, NXCD = 8, WGM = 8;

__host__ __device__ __forceinline__ int lds_byte(int r, int c) { const int st = (r >> 4) * 2 + (c >> 5), rr = r & 15, cc = c & 31, ob = rr * 64 + cc * 2; return st * 1024 + (ob ^ (((ob >> 9) & 1) << 5)); }
__host__ __device__ __forceinline__ void stage_rc(int b, int& R, int& C) { const int st = b / 1024, sb = b % 1024, swz = sb ^ (((sb >> 9) & 1) << 5); R = (st >> 1) * 16 + swz / 64; C = (st & 1) * 32 + (swz % 64) / 2; }
__host__ __device__ __forceinline__ int perm32(int rho) { const int n = rho >> 4, i = rho & 15; return 8 * (i >> 2) + 4 * n + (i & 3); }

struct Unit { int pm, pn, kt0, nt, aux; };
struct Gemm { const bf16_t* A; const bf16_t* Bt; int M, N, K; };

struct StaticOrder {
    int nM, nN, nwg, G, c, ntf, pm0;
    __host__ __device__ void init(int M, int N, int G_, int c_, int K_ = 0, int pm0_ = 0) { nM = M / BM; nN = N / BM; nwg = nM * nN; G = G_; c = c_; ntf = K_ / BK; pm0 = pm0_; }
    __host__ __device__ bool next(int i, Unit& u) const {
        const long L = (long)i * G + c; if (L >= nwg) return false;
        int wgid = (int)L; { const int q = nwg / NXCD, r = nwg % NXCD, xcd = wgid % NXCD, off = wgid / NXCD; wgid = (xcd < r ? xcd * (q + 1) : r * (q + 1) + (xcd - r) * q) + off; }
        const int nig = WGM * nN, gid = wgid / nig, fm = gid * WGM, gsz = (nM - fm) < WGM ? (nM - fm) : WGM;
        u.pm = pm0 + fm + ((wgid % nig) % gsz); u.pn = (wgid % nig) / gsz; u.kt0 = 0; u.nt = ntf; u.aux = 0; return true;
    }
    __device__ __forceinline__ void a_ready(const Unit&) const {}
    __device__ __forceinline__ void done(const Unit&) const {}
};

__device__ __forceinline__ unsigned cvt_pk_bf16(float lo, float hi) { unsigned r; asm volatile("v_cvt_pk_bf16_f32 %0, %1, %2" : "=v"(r) : "v"(lo), "v"(hi)); return r; }
typedef float f32x2 __attribute__((ext_vector_type(2)));

struct EpiStoreBf16 {
    static constexpr bool PERM = true, AFTER_DRAIN = false, MIDK = false;
    bf16_t* O; int ldc;
    __device__ __forceinline__ void operator()(const f32x4 (&acc)[2][2][4][2], const Unit& u, int wr, int wc, int fr, int fq) const {
        const int row0 = u.pm * BM + wr * 64 + fr; const int col0 = u.pn * BM + wc * 32 + 8 * fq;
#pragma unroll
        for (int ai = 0; ai < 2; ++ai)
#pragma unroll
            for (int m = 0; m < 4; ++m) { bf16_t* rowp = O + (size_t)(row0 + ai * HALF + m * 16) * ldc + col0;
#pragma unroll
                for (int bj = 0; bj < 2; ++bj) { const f32x4 v0 = acc[ai][bj][m][0], v1 = acc[ai][bj][m][1];
                    u32x4 w; w.x = cvt_pk_bf16(v0[0], v0[1]); w.y = cvt_pk_bf16(v0[2], v0[3]); w.z = cvt_pk_bf16(v1[0], v1[1]); w.w = cvt_pk_bf16(v1[2], v1[3]);
                    *(u32x4*)(rowp + bj * HALF) = w; } }
    }
};
struct EpiResF32 {
    static constexpr bool PERM = false, AFTER_DRAIN = false, MIDK = false;
    const float* base0; const float* base1; int split_row; float* out; int ldc;
    __device__ __forceinline__ void operator()(const f32x4 (&acc)[2][2][4][2], const Unit& u, int wr, int wc, int fr, int fq) const {
        const int row0 = u.pm * BM + wr * 64 + fr; const int col0 = u.pn * BM + wc * 32 + 4 * fq;
        const float* base = (u.pm * BM >= split_row) ? (base1 - (size_t)split_row * ldc) : base0;
#pragma unroll
        for (int ai = 0; ai < 2; ++ai)
#pragma unroll
            for (int m = 0; m < 4; ++m) { const size_t off = (size_t)(row0 + ai * HALF + m * 16) * ldc + col0;
#pragma unroll
                for (int bj = 0; bj < 2; ++bj)
#pragma unroll
                    for (int n = 0; n < 2; ++n) { const f32x4 b = *(const f32x4*)(base + off + bj * HALF + n * 16); *(f32x4*)(out + off + bj * HALF + n * 16) = b + acc[ai][bj][m][n]; }
                if (m & 1) asm volatile("" ::: "memory"); }
    }
};

struct EpiSlab {
    static constexpr bool PERM = false, AFTER_DRAIN = false, MIDK = false;
    float* slab; const float* ssq_in; int scale_kt;
    __device__ __forceinline__ void operator()(const f32x4 (&acc)[2][2][4][2], const Unit& u, int wr, int wc, int fr, int fq) const {
        float* sp = slab + (size_t)u.aux * 65536 + (wr * 64 + fr) * 256 + wc * 32 + 4 * fq;
        const bool sc = ssq_in != nullptr && u.kt0 < scale_kt;
#pragma unroll
        for (int ai = 0; ai < 2; ++ai)
#pragma unroll
            for (int m = 0; m < 4; ++m) { float r = 1.0f; if (sc) r = 1.0f / sqrtf(ssq_in[u.pm * BM + ai * HALF + wr * 64 + m * 16 + fr] * (1.0f / 2048.0f) + 1e-6f);
#pragma unroll
                for (int bj = 0; bj < 2; ++bj)
#pragma unroll
                    for (int n = 0; n < 2; ++n) *(f32x4*)(sp + (ai * HALF + m * 16) * 256 + bj * HALF + n * 16) = acc[ai][bj][m][n] * r; }
    }
};
struct PieceOrder {
    int G, c, pm0, nN, npieces, ntA, ntB;
    __device__ __forceinline__ bool next(int i, Unit& u) const {
        const int L = i * G + c; if (L >= npieces) return false;
        const int kp = L & 3, tile = L >> 2; u.pn = tile % nN; u.pm = pm0 + tile / nN; u.aux = L;
        if (kp < 2) { u.nt = ntA; u.kt0 = kp * ntA; } else { u.nt = ntB; u.kt0 = 2 * ntA + (kp - 2) * ntB; }
        return true;
    }
    __device__ __forceinline__ void a_ready(const Unit&) const {}
    __device__ __forceinline__ void done(const Unit&) const {}
};

struct EpiResBf16Ssq {
    static constexpr bool PERM = true, AFTER_DRAIN = false, MIDK = true;
    const float* base; bf16_t* O; float* ssq; int ldc; const float* ssq_in;
    __device__ __forceinline__ void midk(f32x4 (&acc)[2][2][4][2], const Unit& u, int wr, int fr) const {
#pragma unroll
        for (int ai = 0; ai < 2; ++ai)
#pragma unroll
            for (int m = 0; m < 4; ++m) { const float r = 1.0f / sqrtf(ssq_in[u.pm * BM + ai * HALF + wr * 64 + m * 16 + fr] * (1.0f / 2048.0f) + 1e-6f);
#pragma unroll
                for (int bj = 0; bj < 2; ++bj)
#pragma unroll
                    for (int n = 0; n < 2; ++n) acc[ai][bj][m][n] *= r; }
    }
    __device__ __forceinline__ void operator()(const f32x4 (&acc)[2][2][4][2], const Unit& u, int wr, int wc, int fr, int fq) const {
        const int row0 = u.pm * BM + wr * 64 + fr; const int col0 = u.pn * BM + wc * 32 + 8 * fq;
#pragma unroll
        for (int ai = 0; ai < 2; ++ai)
#pragma unroll
            for (int m = 0; m < 4; ++m) { const int row = row0 + ai * HALF + m * 16; const size_t off = (size_t)row * ldc + col0; float ss = 0.f;
#pragma unroll
                for (int bj = 0; bj < 2; ++bj) { const f32x4 v0 = *(const f32x4*)(base + off + bj * HALF) + acc[ai][bj][m][0], v1 = *(const f32x4*)(base + off + bj * HALF + 4) + acc[ai][bj][m][1];
                    ss += (v0[0] * v0[0] + v0[1] * v0[1]) + (v0[2] * v0[2] + v0[3] * v0[3]) + (v1[0] * v1[0] + v1[1] * v1[1]) + (v1[2] * v1[2] + v1[3] * v1[3]);
                    u32x4 w; w.x = cvt_pk_bf16(v0[0], v0[1]); w.y = cvt_pk_bf16(v0[2], v0[3]); w.z = cvt_pk_bf16(v1[0], v1[1]); w.w = cvt_pk_bf16(v1[2], v1[3]);
                    *(u32x4*)(O + off + bj * HALF) = w; }
                ss += __shfl_xor(ss, 16); ss += __shfl_xor(ss, 32);
                if (fq == 0) atomicAdd(ssq + row, ss);
                if (m & 1) asm volatile("" ::: "memory"); }
    }
};
struct EpiResFromBf16 {
    static constexpr bool PERM = true, AFTER_DRAIN = false, MIDK = false;
    const bf16_t* X; float* out; int ldc;
    __device__ __forceinline__ void operator()(const f32x4 (&acc)[2][2][4][2], const Unit& u, int wr, int wc, int fr, int fq) const {
        const int row0 = u.pm * BM + wr * 64 + fr; const int col0 = u.pn * BM + wc * 32 + 8 * fq;
#pragma unroll
        for (int ai = 0; ai < 2; ++ai)
#pragma unroll
            for (int m = 0; m < 4; ++m) { const size_t off = (size_t)(row0 + ai * HALF + m * 16) * ldc + col0;
#pragma unroll
                for (int bj = 0; bj < 2; ++bj) { const u32x4 w = *(const u32x4*)(X + off + bj * HALF);
                    f32x4 b0, b1; b0[0] = __uint_as_float(w.x << 16); b0[1] = __uint_as_float(w.x & 0xffff0000u); b0[2] = __uint_as_float(w.y << 16); b0[3] = __uint_as_float(w.y & 0xffff0000u);
                    b1[0] = __uint_as_float(w.z << 16); b1[1] = __uint_as_float(w.z & 0xffff0000u); b1[2] = __uint_as_float(w.w << 16); b1[3] = __uint_as_float(w.w & 0xffff0000u);
                    *(f32x4*)(out + off + bj * HALF) = b0 + acc[ai][bj][m][0]; *(f32x4*)(out + off + bj * HALF + 4) = b1 + acc[ai][bj][m][1]; }
                if (m & 1) asm volatile("" ::: "memory"); }
    }
};

struct ChainOrder {
    StaticOrder S0; int ntA, ntB;
    __device__ __forceinline__ bool next(int i, Unit& u) const { if (!S0.next(i >> 1, u)) return false; if (i & 1) { u.kt0 = ntA; u.nt = ntB; u.aux = 0; } else { u.kt0 = 0; u.nt = ntA; u.aux = 1; } return true; }
    __device__ __forceinline__ void a_ready(const Unit&) const {}
    __device__ __forceinline__ void done(const Unit&) const {}
};

struct HalfMOrder {
    int G, c, ntf;
    __device__ __forceinline__ bool next(int i, Unit& u) const {
        if (G != 256) { const int L = i * G + c; if (L >= 512) return false; u.pm = L >> 4; u.pn = L & 15; u.kt0 = 0; u.nt = ntf; u.aux = 0; return true; }
        if (i >= 2) return false;
        const int xcd = c & 7, r = c >> 3; u.pm = 16 * i + (xcd >> 1) * 4 + (r & 3); u.pn = (xcd & 1) * 8 + (r >> 2); u.kt0 = 0; u.nt = ntf; u.aux = 0; return true;
    }
    __device__ __forceinline__ void a_ready(const Unit&) const {}
    __device__ __forceinline__ void done(const Unit&) const {}
};

struct Gemm3BlockOrder {
    int G, c, ntf;
    __device__ __forceinline__ bool next(int i, Unit& u) const {
        u.kt0 = 0; u.nt = ntf; u.aux = 0;
        if (G != 256) { const int L = i * G + c; if (L >= 3072) return false; if (L < 2752) { u.pm = L / 86; u.pn = L % 86; } else { u.pm = 32 + (L - 2752) / 80; u.pn = (L - 2752) % 80; } return true; }
        if (i >= 12) return false;
        const int x = c & 7, r = c >> 3, k = i * 8 + x;
        if (k < 84) { const int g = k / 21, jb = k % 21; u.pm = 8 * g + (r & 7); u.pn = 4 * jb + (r >> 3); }
        else if (k < 94) { const int jb = k - 84; u.pm = 32 + (r & 3); u.pn = 8 * jb + (r >> 2); }
        else { const int g = 2 * (k - 94) + (r >> 4); u.pm = 8 * g + (r & 7); u.pn = 84 + ((r >> 3) & 1); }
        return true;
    }
    __device__ __forceinline__ void a_ready(const Unit&) const {}
    __device__ __forceinline__ void done(const Unit&) const {}
};
struct TailPieceOrder {
    int G, c, npieces;
    __device__ __forceinline__ bool next(int i, Unit& u) const { const int L = i * G + c; if (L >= npieces) return false; const int t = L >> 3; u.pm = 32 + (t & 3); u.pn = 80 + (t >> 2); u.kt0 = 8 * (L & 7); u.nt = 8; u.aux = L; return true; }
    __device__ __forceinline__ void a_ready(const Unit&) const {}
    __device__ __forceinline__ void done(const Unit&) const {}
};
struct Gemm1BlockOrder {
    int G, c, ntf;
    __device__ __forceinline__ bool next(int i, Unit& u) const {
        u.kt0 = 0; u.nt = ntf; u.aux = 0;
        if (G != 256) { const int L = i * G + c; if (L >= 1332) return false; u.pm = L / 37; u.pn = L % 37; return true; }
        if (i < 5) { const int x = c & 7, r = c >> 3, k = i * 8 + x;
            if (k < 36) { const int g = k / 9, jb = k % 9; u.pm = 8 * g + (r & 7); u.pn = 4 * jb + (r >> 3); } else { const int jb = k - 36; u.pm = 32 + (r & 3); u.pn = 8 * jb + (r >> 2); }
            return true; }
        if (i > 5 || c >= 52) return false;
        if (c < 32) { u.pm = c; u.pn = 36; } else { const int s = c - 32; u.pm = 32 + (s & 3); u.pn = 32 + (s >> 2); }
        return true;
    }
    __device__ __forceinline__ void a_ready(const Unit&) const {}
    __device__ __forceinline__ void done(const Unit&) const {}
};
struct EpiSlabPerm {
    static constexpr bool PERM = true, AFTER_DRAIN = false, MIDK = false;
    float* slab;
    __device__ __forceinline__ void operator()(const f32x4 (&acc)[2][2][4][2], const Unit& u, int wr, int wc, int fr, int fq) const {
        float* sp = slab + (size_t)u.aux * 65536 + (wr * 64 + fr) * 256 + wc * 32 + 8 * fq;
#pragma unroll
        for (int ai = 0; ai < 2; ++ai)
#pragma unroll
            for (int m = 0; m < 4; ++m)
#pragma unroll
                for (int bj = 0; bj < 2; ++bj)
#pragma unroll
                    for (int n = 0; n < 2; ++n) *(f32x4*)(sp + (ai * HALF + m * 16) * 256 + bj * HALF + 4 * n) = acc[ai][bj][m][n];
    }
};
template <class Epi, class Sched, bool ALIGN_EPI = false, bool SP2 = false, bool A_TILED = false, bool B_TILED = false>
__device__ __forceinline__ void gemm_phase(PG8_LAS unsigned char* lds, const Gemm g, const Sched& S, const Epi& E) {
    const int tid = threadIdx.x, wid = __builtin_amdgcn_readfirstlane(tid >> 6), lane = tid & 63, wr = wid >> 2, wc = wid & 3, fr = lane & 15, fq = lane >> 4;
    const int K = g.K; int nt;
    unsigned voffA[2], voffB[2];
#pragma unroll
    for (int i = 0; i < 2; ++i) { int R, C; stage_rc(tid * 16 + i * 8192, R, C); const int Rb = Epi::PERM ? ((R & ~31) + perm32(R & 31)) : R;
        voffA[i] = A_TILED ? (unsigned)(R * BK + C) * 2u : (unsigned)(R * K + C) * 2u; voffB[i] = B_TILED ? (unsigned)(Rb * BK + C) * 2u : (unsigned)(Rb * K + C) * 2u; }
    const size_t kstep = (size_t)(BK * 2);
    const size_t hstep = (size_t)HALF * K * 2;
    const size_t tstep = 2 * hstep;
    const size_t kstepA = A_TILED ? (size_t)(BM * BK * 2) : kstep, hstepA = A_TILED ? (size_t)(HALF * BK * 2) : hstep, kstepB = B_TILED ? (size_t)(BM * BK * 2) : kstep, hstepB = B_TILED ? (size_t)(HALF * BK * 2) : hstep;
    const unsigned ldsw = (unsigned)wid * 1024u;
    const int aoff = lds_byte(wr * 64 + fr, fq * 8), boff = lds_byte(wc * 32 + fr, fq * 8);
#define PG8_SA(b, h) (((b) * 2 + (h)) * HTB)
#define PG8_SB(b, h) ((4 + (b) * 2 + (h)) * HTB)
#define PG8_STAGE(bufoff, gbase, voff) do { _Pragma("unroll") for (int _i = 0; _i < 2; ++_i) \
        __builtin_amdgcn_global_load_lds((const unsigned*)((const char*)(gbase) + (voff)[_i]), (PG8_LAS unsigned*)(lds + (bufoff) + ldsw + _i * 8192), 16, 0, 0); } while (0)
#define PG8_LDA(dst, b, h) do { _Pragma("unroll") for (int m = 0; m < 4; ++m) _Pragma("unroll") for (int k = 0; k < 2; ++k) dst[m][k] = *(const PG8_LAS bf16x8*)(lds + PG8_SA(b, h) + aoff + m * 2048 + k * 1024); } while (0)
#define PG8_LDB(dst, b, h) do { _Pragma("unroll") for (int n = 0; n < 2; ++n) _Pragma("unroll") for (int k = 0; k < 2; ++k) dst[n][k] = *(const PG8_LAS bf16x8*)(lds + PG8_SB(b, h) + boff + n * 2048 + k * 1024); } while (0)
#define PG8_MMA(ai, bj, At, Bt) do { __builtin_amdgcn_s_setprio(1); _Pragma("unroll") for (int m = 0; m < 4; ++m) _Pragma("unroll") for (int n = 0; n < 2; ++n) _Pragma("unroll") for (int k = 0; k < 2; ++k) \
        acc[ai][bj][m][n] = __builtin_amdgcn_mfma_f32_16x16x32_bf16(Bt[n][k], At[m][k], acc[ai][bj][m][n], 0, 0, 0); __builtin_amdgcn_s_setprio(0); } while (0)
#define PG8_WAIT_V(n) asm volatile("s_waitcnt vmcnt(" #n ")" ::: "memory")
#define PG8_WAIT_L(n) asm volatile("s_waitcnt lgkmcnt(" #n ")" ::: "memory")
#define PG8_BAR __builtin_amdgcn_s_barrier()
#define PG8_SCHED __builtin_amdgcn_sched_barrier(0)
    Unit cur, nxt; int ui = 0;
    if (!S.next(0, cur)) return;
    nt = cur.nt;
    f32x4 acc[2][2][4][2];
#pragma unroll
    for (int a = 0; a < 2; ++a)
#pragma unroll
        for (int b = 0; b < 2; ++b)
#pragma unroll
            for (int m = 0; m < 4; ++m)
#pragma unroll
                for (int n = 0; n < 2; ++n) acc[a][b][m][n] = (f32x4){0.f, 0.f, 0.f, 0.f};
    bf16x8 At[4][2], B0[2][2], B1[2][2];
    const char* cA = (const char*)g.A + (size_t)cur.pm * tstep + (size_t)cur.kt0 * kstepA; const char* cB = (const char*)g.Bt + (size_t)cur.pn * tstep + (size_t)cur.kt0 * kstepB;
    S.a_ready(cur);
    if constexpr (SP2) {
        PG8_STAGE(PG8_SB(0, 0), cB, voffB); PG8_STAGE(PG8_SB(0, 1), cB + hstepB, voffB); PG8_STAGE(PG8_SA(0, 0), cA, voffA); PG8_STAGE(PG8_SA(0, 1), cA + hstepA, voffA);
        if (wr == 1) PG8_BAR;
        PG8_WAIT_V(2); PG8_BAR;
        PG8_STAGE(PG8_SB(1, 0), cB + kstepB, voffB); PG8_STAGE(PG8_SA(1, 0), cA + kstepA, voffA); PG8_STAGE(PG8_SB(1, 1), cB + hstepB + kstepB, voffB);
        PG8_WAIT_V(6); PG8_BAR;
    } else {
        PG8_STAGE(PG8_SB(0, 0), cB, voffB); PG8_STAGE(PG8_SA(0, 0), cA, voffA); PG8_STAGE(PG8_SB(0, 1), cB + hstepB, voffB); PG8_STAGE(PG8_SA(0, 1), cA + hstepA, voffA);
        if (wr == 1) PG8_BAR;
        PG8_WAIT_V(4); PG8_BAR;
        PG8_STAGE(PG8_SB(1, 0), cB + kstepB, voffB); PG8_STAGE(PG8_SA(1, 0), cA + kstepA, voffA); PG8_STAGE(PG8_SB(1, 1), cB + hstepB + kstepB, voffB);
        PG8_WAIT_V(6); PG8_BAR;
    }
    for (;;) {
        const bool has_next = S.next(ui + 1, nxt);
        const char* nA = has_next ? (const char*)g.A + (size_t)nxt.pm * tstep + (size_t)nxt.kt0 * kstepA : cA; const char* nB = has_next ? (const char*)g.Bt + (size_t)nxt.pn * tstep + (size_t)nxt.kt0 * kstepB : cB;
        for (int t = 0; t < nt; t += 2) {
            const bool last = (t == nt - 2);
            const char* a1 = cA + (size_t)(t + 1) * kstepA;
            const char* a2 = last ? nA : cA + (size_t)(t + 2) * kstepA; const char* b2 = last ? nB : cB + (size_t)(t + 2) * kstepB;
            const char* a3 = a2 + kstepA; const char* b3 = b2 + kstepB;
            if (last && has_next) S.a_ready(nxt);
            if constexpr (SP2) {
            PG8_LDB(B0, 0, 0); PG8_LDB(B1, 0, 1); PG8_SCHED; PG8_LDA(At, 0, 0); PG8_STAGE(PG8_SA(1, 1), a1 + hstepA, voffA);
            PG8_WAIT_V(8); PG8_WAIT_L(0); PG8_BAR; PG8_MMA(0, 0, At, B0); PG8_MMA(0, 1, At, B1); PG8_BAR; PG8_SCHED;
            PG8_LDA(At, 0, 1); PG8_STAGE(PG8_SB(0, 0), b2, voffB); PG8_STAGE(PG8_SB(0, 1), b2 + hstepB, voffB); PG8_STAGE(PG8_SA(0, 0), a2, voffA);
            PG8_WAIT_V(8); PG8_WAIT_L(0); PG8_BAR; PG8_MMA(1, 0, At, B0); PG8_MMA(1, 1, At, B1); PG8_BAR; PG8_SCHED;
            PG8_LDB(B0, 1, 0); PG8_LDB(B1, 1, 1); PG8_SCHED; PG8_LDA(At, 1, 0); PG8_STAGE(PG8_SA(0, 1), a2 + hstepA, voffA);
            PG8_WAIT_V(8); PG8_WAIT_L(0); PG8_BAR; PG8_MMA(0, 0, At, B0); PG8_MMA(0, 1, At, B1); PG8_BAR; PG8_SCHED;
            PG8_LDA(At, 1, 1); PG8_STAGE(PG8_SB(1, 0), b3, voffB); PG8_STAGE(PG8_SB(1, 1), b3 + hstepB, voffB); PG8_STAGE(PG8_SA(1, 0), a3, voffA);
            PG8_WAIT_V(8); PG8_WAIT_L(0); PG8_BAR; PG8_MMA(1, 0, At, B0); PG8_MMA(1, 1, At, B1); PG8_BAR; PG8_SCHED;
            } else {
            PG8_LDB(B0, 0, 0); PG8_SCHED; PG8_LDA(At, 0, 0); PG8_STAGE(PG8_SA(1, 1), a1 + hstepA, voffA);
            PG8_WAIT_L(8); PG8_BAR; PG8_WAIT_L(0); PG8_MMA(0, 0, At, B0); PG8_BAR; PG8_SCHED;
            PG8_LDB(B1, 0, 1); PG8_STAGE(PG8_SB(0, 0), b2, voffB);
            PG8_BAR; PG8_WAIT_L(0); PG8_MMA(0, 1, At, B1); PG8_BAR;
            PG8_LDA(At, 0, 1); PG8_STAGE(PG8_SA(0, 0), a2, voffA);
            PG8_BAR; PG8_WAIT_L(0); PG8_MMA(1, 0, At, B0); PG8_BAR; PG8_SCHED;
            PG8_STAGE(PG8_SB(0, 1), b2 + hstepB, voffB);
            PG8_WAIT_V(6); PG8_BAR; PG8_MMA(1, 1, At, B1); PG8_BAR;
            PG8_LDB(B0, 1, 0); PG8_SCHED; PG8_LDA(At, 1, 0); PG8_STAGE(PG8_SA(0, 1), a2 + hstepA, voffA);
            PG8_WAIT_L(8); PG8_BAR; PG8_WAIT_L(0); PG8_MMA(0, 0, At, B0); PG8_BAR; PG8_SCHED;
            PG8_LDB(B1, 1, 1); PG8_STAGE(PG8_SB(1, 0), b3, voffB);
            PG8_BAR; PG8_WAIT_L(0); PG8_MMA(0, 1, At, B1); PG8_BAR;
            PG8_LDA(At, 1, 1); PG8_STAGE(PG8_SA(1, 0), a3, voffA);
            PG8_BAR; PG8_WAIT_L(0); PG8_MMA(1, 0, At, B0); PG8_BAR; PG8_SCHED;
            PG8_STAGE(PG8_SB(1, 1), b3 + hstepB, voffB);
            PG8_WAIT_V(6); PG8_BAR; PG8_MMA(1, 1, At, B1); PG8_BAR;
            }
        }
        if constexpr (ALIGN_EPI) { if (wr == 0) PG8_BAR; }
        bool chain = false; if constexpr (Epi::MIDK) chain = (cur.aux == 1);
        if constexpr (Epi::MIDK) { if (chain) E.midk(acc, cur, wr, fr); }
        if constexpr (!Epi::AFTER_DRAIN) { if (!chain) { E(acc, cur, wr, wc, fr, fq); S.done(cur); } }
        if (!has_next) break;
        if (!chain) {
#pragma unroll
        for (int a = 0; a < 2; ++a)
#pragma unroll
            for (int b = 0; b < 2; ++b)
#pragma unroll
                for (int m = 0; m < 4; ++m)
#pragma unroll
                    for (int n = 0; n < 2; ++n) acc[a][b][m][n] = (f32x4){0.f, 0.f, 0.f, 0.f};
        }
        cur = nxt; cA = nA; cB = nB; ++ui; nt = cur.nt;
        if constexpr (ALIGN_EPI) { if (wr == 1) PG8_BAR; }
    }
    PG8_WAIT_V(0);
    if constexpr (!ALIGN_EPI) { if (wr == 0) PG8_BAR; }
    PG8_BAR;
    if constexpr (Epi::AFTER_DRAIN) { E.fused(acc, cur, wr, wc, fr, fq, lds, wid, lane); S.done(cur); }
#undef PG8_SA
#undef PG8_SB
#undef PG8_STAGE
#undef PG8_LDA
#undef PG8_LDB
#undef PG8_MMA
#undef PG8_WAIT_V
#undef PG8_WAIT_L
#undef PG8_BAR
#undef PG8_SCHED
}
}
#ifndef PG8_SP2
#define PG8_SP2 true
#endif
#ifndef PG8_ALIGN
#define PG8_ALIGN true
#endif
#ifndef MK_N_LAUNCHES
#define MK_N_LAUNCHES 1
#endif
constexpr int N_LAUNCHES = MK_N_LAUNCHES;
constexpr int N_PHASES = 11;
constexpr int NWAVES = 8;

constexpr int DM = 4096, SEQ = 2048, NBP = 4, MP = NBP * SEQ, NBS = 128, LS = 8, MS = NBS * LS, M = MP + MS;
constexpr int C_Q = 0, C_K = 2048, C_V = 2560, C_Z = 3072, C_X = 5120, C_DT = 9216, LDP = 9472;
constexpr int DFF = 11008, NGU = 2 * DFF;
constexpr float EPS = 1e-6f, LOG2E = 1.4426950408889634f;

constexpr size_t O_YP = 0, O_YS = 33554432, O_PK = 37748736, O_PV = 38010880, O_PSSM = 38273024, O_PCONV = 39321600, O_PFFN = 39370752,
                 O_SK = 39458816, O_SV = 47847424, O_SSSM = 56236032, O_SCONV = 89790464, O_SFFN = 91363328, O_END = 94181376;

constexpr size_t MiB = 1u << 20;
constexpr size_t WS_CTL = 0, CTL_ZERO_BYTES = 1 * MiB;
constexpr size_t WS_W3 = 2 * MiB;
constexpr size_t WS_W4 = 174 * MiB;
constexpr size_t WS_XN = 260 * MiB;
constexpr size_t WS_W1 = 332 * MiB;
constexpr size_t WS_W2 = 406 * MiB;
constexpr size_t WS_PROJ = 438 * MiB;
constexpr size_t WS_MIX = 605 * MiB;
constexpr size_t WS_GU = 332 * MiB;
constexpr size_t WS_ACT = 719 * MiB;
constexpr size_t WS_SLAB = 332 * MiB;
constexpr size_t WS_XBCC = 332 * MiB;
constexpr size_t WS_FIX = 680 * MiB;
constexpr size_t WS_END = 913 * MiB;
static_assert(WS_W3 + (size_t)NGU * DM * 2 <= WS_W4 && WS_W4 + (size_t)DM * DFF * 2 <= WS_XN && WS_XN + (size_t)M * DM * 2 <= WS_W1 && WS_W1 + (size_t)LDP * DM * 2 <= WS_W2 &&
              WS_W2 + (size_t)DM * DM * 2 <= WS_PROJ && WS_PROJ + (size_t)M * LDP * 2 <= WS_MIX && WS_MIX + (size_t)M * DM * 2 <= WS_ACT && WS_GU + (size_t)M * NGU * 2 <= WS_ACT &&
              WS_ACT + (size_t)M * DFF * 2 <= WS_END, "d_ws map");

constexpr int CW_TMO = 0, CW_CODE = 1, CW_BAR = 4096, CW_Q = 8192  , CW_SSQ = 16384  , CW_SSQ2 = 36864  ;

constexpr int RING_OFF = 0, RING_BYTES = 131072;
constexpr int TB_OFF = 131072;
constexpr int CWL_OFF = TB_OFF + 8192;
constexpr int LDSCTL_OFF = CWL_OFF + 6400, MISC_OFF = LDSCTL_OFF + 320;
constexpr int LDS_BYTES = 147456;
static_assert(MISC_OFF + 128 <= LDS_BYTES && (MISC_OFF % 16) == 0, "LDS map");

#define GAS __attribute__((address_space(1)))
#define LAS __attribute__((address_space(3)))
typedef unsigned short bf16;
typedef unsigned u32x4 __attribute__((ext_vector_type(4)));
typedef unsigned u32x2 __attribute__((ext_vector_type(2)));
typedef float f32x4 __attribute__((ext_vector_type(4)));
typedef float f32x16 __attribute__((ext_vector_type(16)));
typedef short bf16x8 __attribute__((ext_vector_type(8)));
typedef short s16x4 __attribute__((ext_vector_type(4)));
typedef short v4i16_t __attribute__((ext_vector_type(4)));
typedef GAS unsigned gu32;
#define RLX_AGENT __ATOMIC_RELAXED, __HIP_MEMORY_SCOPE_AGENT
#define LDS_WAIT() asm volatile("s_waitcnt lgkmcnt(0)" ::: "memory")
#define VM_WAIT() asm volatile("s_waitcnt vmcnt(0)" ::: "memory")
#define MFMA32(a, b, c) __builtin_amdgcn_mfma_f32_32x32x16_bf16((a), (b), (c), 0, 0, 0)
typedef float f32x2_t __attribute__((ext_vector_type(2)));
typedef __bf16 bf16x2_t __attribute__((ext_vector_type(2)));
__device__ __forceinline__ unsigned cvtpk(float lo, float hi) { f32x2_t v = {lo, hi}; bf16x2_t b = __builtin_convertvector(v, bf16x2_t); return __builtin_bit_cast(unsigned, b); }
__device__ __forceinline__ float bf2f(unsigned short h) { return __uint_as_float((unsigned)h << 16); }
__device__ __forceinline__ float bflo(unsigned w) { return __uint_as_float(w << 16); }
__device__ __forceinline__ float bfhi(unsigned w) { return __uint_as_float(w & 0xffff0000u); }
__device__ __forceinline__ void unpack8(const u32x4 w, float (&f)[8]) { f[0] = bflo(w.x); f[1] = bfhi(w.x); f[2] = bflo(w.y); f[3] = bfhi(w.y); f[4] = bflo(w.z); f[5] = bfhi(w.z); f[6] = bflo(w.w); f[7] = bfhi(w.w); }
__device__ __forceinline__ u32x4 pack8(const float (&f)[8]) { u32x4 w; w.x = cvtpk(f[0], f[1]); w.y = cvtpk(f[2], f[3]); w.z = cvtpk(f[4], f[5]); w.w = cvtpk(f[6], f[7]); return w; }
__device__ __forceinline__ float silu_f(float x) { return x * __builtin_amdgcn_rcpf(1.0f + __expf(-x)); }
__device__ __forceinline__ float softplus_f(float x) { return x > 20.f ? x : log1pf(__expf(x)); }
__device__ __forceinline__ int crow(int r, int hi) { return (r & 3) + 8 * (r >> 2) + 4 * hi; }
__device__ __forceinline__ s16x4 vtr(const LAS unsigned char* p) { return __builtin_bit_cast(s16x4, __builtin_amdgcn_ds_read_tr16_b64_v4i16((LAS v4i16_t*)p)); }
__device__ __forceinline__ bf16x8 cat4(s16x4 a, s16x4 b) { bf16x8 r; r[0] = a[0]; r[1] = a[1]; r[2] = a[2]; r[3] = a[3]; r[4] = b[0]; r[5] = b[1]; r[6] = b[2]; r[7] = b[3]; return r; }
__device__ __forceinline__ bf16x8 pack_step(const f32x16& x, int s) {
    u32x4 p; p.x = cvtpk(x[8 * s], x[8 * s + 1]); p.y = cvtpk(x[8 * s + 2], x[8 * s + 3]); p.z = cvtpk(x[8 * s + 4], x[8 * s + 5]); p.w = cvtpk(x[8 * s + 6], x[8 * s + 7]);
    return __builtin_bit_cast(bf16x8, p);
}
__device__ __forceinline__ float wave_sum(float v) {
#pragma unroll
    for (int o = 1; o < 64; o <<= 1) v += __shfl_xor(v, o);
    return v;
}

struct Args { const float* in[26]; float* out; unsigned char* ws; int ph_lo, ph_hi, grid, pad; };
#define KARG ((const __attribute__((address_space(4))) Args*)__builtin_amdgcn_kernarg_segment_ptr())
#define P_x_prompt (KARG->in[0])
#define P_x_sample (KARG->in[1])
#define P_st_k (KARG->in[2])
#define P_st_v (KARG->in[3])
#define P_st_ssm (KARG->in[4])
#define P_st_conv (KARG->in[5])
#define P_st_ffn (KARG->in[6])
#define P_rel_bias (KARG->in[7])
#define P_mix_nw (KARG->in[8])
#define P_w_in (KARG->in[9])
#define P_q_nw (KARG->in[10])
#define P_k_nw (KARG->in[11])
#define P_sinks (KARG->in[12])
#define P_conv_w (KARG->in[13])
#define P_conv_b (KARG->in[14])
#define P_dt_bias (KARG->in[15])
#define P_A_log (KARG->in[16])
#define P_Dv (KARG->in[17])
#define P_ssd_nw (KARG->in[18])
#define P_w_out (KARG->in[19])
#define P_ffn_nw (KARG->in[20])
#define P_w_gate (KARG->in[21])
#define P_w_up (KARG->in[22])
#define P_fconv_w (KARG->in[23])
#define P_fconv_b (KARG->in[24])
#define P_w_down (KARG->in[25])
#define P_out (KARG->out)
#define P_ws (KARG->ws)
#define P_W1 ((bf16*)(P_ws + WS_W1))
#define P_W2 ((bf16*)(P_ws + WS_W2))
#define P_W3 ((bf16*)(P_ws + WS_W3))
#define P_W4 ((bf16*)(P_ws + WS_W4))
#define P_XN ((bf16*)(P_ws + WS_XN))
#define P_PROJ ((bf16*)(P_ws + WS_PROJ))
#define P_MIX ((bf16*)(P_ws + WS_MIX))
#define P_ACT ((bf16*)(P_ws + WS_ACT))
#define P_X1B ((bf16*)(P_ws + WS_PROJ))
#define P_ssq2 ((float*)(P_ws + WS_CTL) + CW_SSQ2)
#define P_ctl ((gu32*)(P_ws + WS_CTL))
#define P_ssq ((float*)(P_ws + WS_CTL) + CW_SSQ)
struct Ptrs {};

namespace pg8 {
__device__ __forceinline__ float dpp_shr1(float old, float src) { return __builtin_bit_cast(float, __builtin_amdgcn_update_dpp(__builtin_bit_cast(int, old), __builtin_bit_cast(int, src), 0x111, 0xf, 0xf, false)); }
__device__ __forceinline__ float dpp_shr2(float old, float src) { return __builtin_bit_cast(float, __builtin_amdgcn_update_dpp(__builtin_bit_cast(int, old), __builtin_bit_cast(int, src), 0x112, 0xf, 0xf, false)); }
__device__ __forceinline__ float dpp_ror1(float src) { return __builtin_bit_cast(float, __builtin_amdgcn_update_dpp(0, __builtin_bit_cast(int, src), 0x121, 0xf, 0xf, false)); }
__device__ __forceinline__ float dpp_ror2(float src) { return __builtin_bit_cast(float, __builtin_amdgcn_update_dpp(0, __builtin_bit_cast(int, src), 0x122, 0xf, 0xf, false)); }
__device__ __forceinline__ size_t act_off(int r, int j) { return ((size_t)((r >> 8) * (DFF / 64) + (j >> 6)) * 256 + (r & 255)) * 64 + (j & 63); }
__device__ __forceinline__ float silu_e(float x) { return x * __builtin_amdgcn_rcpf(1.0f + __expf(-x)); }
struct EpiGateUp {
    static constexpr bool PERM = true, AFTER_DRAIN = false, MIDK = false;
    bf16_t* ACT; const float* cw; const float* cb; const float* st_ffn; float* fix; float* out; PG8_LAS float* E; const float* ssq;
    __device__ __forceinline__ void operator()(const f32x4 (&acc)[2][2][4][2], const Unit& u, int wr, int wc, int fr, int fq) const {
        asm volatile("" : "+v"(fr), "+v"(fq));
        const int jl = wc * 32 + 8 * fq, j0 = u.pn * 128 + jl;
        const bool sample = u.pm >= MP / 256;
        const float* sq = ssq + u.pm * BM + wr * 64 + fr;
#define RSTD(ai_, m_) (1.0f / sqrtf(sq[(ai_) * HALF + (m_) * 16] * (1.0f / DM) + EPS))
        PG8_LAS float* const T = E - 2048;
        { const int tid_ = threadIdx.x; if (tid_ < 256) E[1024 + tid_] = 1.0f / sqrtf(ssq[u.pm * BM + tid_] * (1.0f / DM) + EPS);
          else { const int wv_ = __builtin_amdgcn_readfirstlane(tid_ >> 6) - 4; int l2_ = 2 * (tid_ & 63); asm volatile("" : "+v"(l2_));
                 const float* src_ = ((wv_ == 3) ? cb : cw + (size_t)wv_ * DFF) + u.pn * 128; typedef float f32x2e __attribute__((ext_vector_type(2)));
                 *(PG8_LAS f32x2e*)(T + wv_ * 128 + l2_) = *(const f32x2e*)(src_ + l2_); } }
        if (fr >= 14) {
#pragma unroll
            for (int ai = 0; ai < 2; ++ai)
#pragma unroll
                for (int n = 0; n < 2; ++n) *(PG8_LAS f32x4*)(E + ((ai * 2 + wr) * 2 + (fr - 14)) * 128 + jl + 4 * n) = acc[ai][0][3][n] * RSTD(ai, 3);
            if (!sample && wr == 1) {
#pragma unroll
                for (int n = 0; n < 2; ++n) { const f32x4 gh = acc[1][0][3][n] * RSTD(1, 3); *(f32x4*)(fix + ((size_t)u.pm * 2 + (fr - 14)) * DFF + j0 + 4 * n) = gh;
                    if ((u.pm & 7) == 7) *(f32x4*)(out + O_PFFN + ((size_t)(u.pm >> 3) * 2 + (fr - 14)) * DFF + j0 + 4 * n) = gh; }
            }
        }
        asm volatile("s_waitcnt lgkmcnt(0)" ::: "memory"); __builtin_amdgcn_s_barrier(); asm volatile("" ::: "memory");
        typedef unsigned u32x2e __attribute__((ext_vector_type(2))); typedef unsigned u32x4e __attribute__((ext_vector_type(4)));
        u32x2e keep[2][4];
#pragma unroll
        for (int n = 0; n < 2; ++n) {
            const f32x4 w0 = *(const PG8_LAS f32x4*)(T + jl + 4 * n), w1 = *(const PG8_LAS f32x4*)(T + 128 + jl + 4 * n), w2 = *(const PG8_LAS f32x4*)(T + 256 + jl + 4 * n), bb = *(const PG8_LAS f32x4*)(T + 384 + jl + 4 * n);
#pragma unroll
            for (int ai = 0; ai < 2; ++ai) {
                const PG8_LAS float* RS = E + 1024 + ai * HALF + wr * 64 + fr;
                f32x4 bm1 = (f32x4){0.f, 0.f, 0.f, 0.f}, bm2 = bm1;
                if (!sample && (wr == 1 || ai == 1)) { const int sa = (wr == 1) ? ai : 0, sw = (wr == 1) ? 0 : 1;
                    bm2 = *(const PG8_LAS f32x4*)(E + ((sa * 2 + sw) * 2 + 0) * 128 + jl + 4 * n); bm1 = *(const PG8_LAS f32x4*)(E + ((sa * 2 + sw) * 2 + 1) * 128 + jl + 4 * n); }
#pragma unroll
                for (int m = 0; m < 4; ++m) {
                    const int r = u.pm * BM + ai * HALF + wr * 64 + m * 16 + fr;
                    const float rsm = RS[16 * m]; const f32x4 g = acc[ai][0][m][n] * rsm, uu = acc[ai][1][m][n] * rsm; f32x4 p1, p2, av;
                    if (!sample) {
#pragma unroll
                        for (int e = 0; e < 4; ++e) { float o1, o2;
                            if (m == 0) { o1 = bm1[e]; o2 = (fr == 0) ? bm2[e] : bm1[e]; } else { const float gp = acc[ai][0][m > 0 ? m - 1 : 0][n][e] * RS[16 * (m > 0 ? m - 1 : 0)]; o1 = dpp_ror1(gp); o2 = dpp_ror2(gp); }
                            p1[e] = dpp_shr1(o1, g[e]); p2[e] = dpp_shr2(o2, g[e]); }
                        if (ai == 0 && wr == 0 && m == 0 && fr < 2 && (u.pm & 7) != 0) {
                            *(f32x4*)(fix + ((size_t)(72 + u.pm * 2 + fr)) * DFF + j0 + 4 * n) = g; *(f32x4*)(fix + ((size_t)(144 + u.pm * 2 + fr)) * DFF + j0 + 4 * n) = uu; }
                    } else {
                        const int t = fr & 7, bs = (r - MP) >> 3; f32x4 s0 = (f32x4){0.f, 0.f, 0.f, 0.f}, s1 = s0;
                        if (t < 2) { s0 = *(const f32x4*)(st_ffn + ((size_t)bs * 2 + 0) * DFF + j0 + 4 * n); s1 = *(const f32x4*)(st_ffn + ((size_t)bs * 2 + 1) * DFF + j0 + 4 * n); }
#pragma unroll
                        for (int e = 0; e < 4; ++e) { const float a1 = dpp_shr1(0.f, g[e]), a2 = dpp_shr2(0.f, g[e]); p1[e] = (t >= 1) ? a1 : s1[e]; p2[e] = (t >= 2) ? a2 : (t == 1 ? s1[e] : s0[e]); }
                        if (t >= 6) *(f32x4*)(out + O_SFFN + ((size_t)bs * 2 + (t - 6)) * DFF + j0 + 4 * n) = g;
                    }
                    const f32x4 gc = bb + w0 * p2 + w1 * p1 + w2 * g;
#pragma unroll
                    for (int e = 0; e < 4; ++e) av[e] = silu_e(gc[e]) * uu[e];
                    if (n == 0) { keep[ai][m].x = cvt_pk_bf16(av[0], av[1]); keep[ai][m].y = cvt_pk_bf16(av[2], av[3]); }
                    else { u32x4e w; w.x = keep[ai][m].x; w.y = keep[ai][m].y; w.z = cvt_pk_bf16(av[0], av[1]); w.w = cvt_pk_bf16(av[2], av[3]); *(u32x4e*)(ACT + act_off(r, j0)) = w; }
                }
            }
        }
#undef RSTD
    }
};
}
#define XB_TMO      128
#define XB_XCNT(j)  (256  + 64 * (j))
#define XB_XSUB(j)  (1280 + 64 * (j))
#define XB_XGEN(j)  (2304 + 64 * (j))
#define XB_TOP      3328
#define XB_TOPGEN   3392
#define XCD_BAR_WORDS 3456
#define XB_SPIN_CAP (1u << 18)

__device__ __forceinline__ unsigned xb_ld(unsigned* p)              { return __hip_atomic_load(p, __ATOMIC_RELAXED, __HIP_MEMORY_SCOPE_AGENT); }
__device__ __forceinline__ unsigned xb_add(unsigned* p, unsigned v) { return __hip_atomic_fetch_add(p, v, __ATOMIC_RELAXED, __HIP_MEMORY_SCOPE_AGENT); }
__device__ __forceinline__ unsigned xb_xcc_id() { return (unsigned)__builtin_amdgcn_s_getreg((3 << 11) | 20) & 0xFu; }
#define XB_SPIN(cond, bar) do { unsigned _sp = 0; while (cond) { __builtin_amdgcn_s_sleep(1); \
    if ((++_sp & 255u) == 0u) { if (xb_ld(&(bar)[XB_TMO])) break; if (_sp > XB_SPIN_CAP) { atomicAdd(&(bar)[XB_TMO], 1u); break; } } } } while (0)

struct XcdBarrier {
    unsigned* bar; unsigned x;
    volatile LAS unsigned* st;
};

__device__ __forceinline__ XcdBarrier xcd_barrier_post(unsigned* bar, volatile LAS unsigned* st) {
    XcdBarrier b; b.bar = bar; b.x = xb_xcc_id(); b.st = st;
    if (threadIdx.x == 0) (void)xb_add(&bar[XB_XCNT(b.x)], 1u);
    return b;
}
__device__ __forceinline__ void xcd_barrier_complete(unsigned* bar, unsigned x, unsigned& nloc, unsigned& nx) {
    const unsigned G = (unsigned)KARG->grid;
    unsigned sum, cnt, mine, sp = 0u;
    for (;;) {
        sum = 0u; cnt = 0u; mine = 0u;
#pragma unroll
        for (unsigned j = 0; j < 16; ++j) { const unsigned c = xb_ld(&bar[XB_XCNT(j)]); sum += c; cnt += (c > 0u) ? 1u : 0u; mine = (j == x) ? c : mine; }
        if (sum == G) break;
        __builtin_amdgcn_s_sleep(1);
        if ((++sp & 255u) == 0u) { if (xb_ld(&bar[XB_TMO])) break; if (sp > XB_SPIN_CAP) { atomicAdd(&bar[XB_TMO], 1u); break; } }
    }
    nloc = mine > 0u ? mine : 1u; nx = cnt > 0u ? cnt : 1u;
}

__device__ __forceinline__ void xcd_barrier(const XcdBarrier& b) {
    asm volatile("s_waitcnt vmcnt(0)" ::: "memory");
    __syncthreads();
    if (threadIdx.x == 0) {
        unsigned* bar = b.bar;
        __builtin_amdgcn_s_waitcnt(0);
        unsigned nloc = b.st[0], nx = b.st[1];
        if (nloc == 0u) { xcd_barrier_complete(bar, b.x, nloc, nx); b.st[0] = nloc; b.st[1] = nx; }
        const unsigned old = xb_add(&bar[XB_XSUB(b.x)], 1u);
        const unsigned gen = old / nloc;
        if (old + 1u == (gen + 1u) * nloc) {
            __builtin_amdgcn_fence(__ATOMIC_RELEASE, "agent");
            asm volatile("s_waitcnt vmcnt(0)" ::: "memory");
            const unsigned og = xb_add(&bar[XB_TOP], 1u);
            const unsigned tg = og / nx;
            if (og + 1u == (tg + 1u) * nx) xb_add(&bar[XB_TOPGEN], 1u);
            else XB_SPIN(xb_ld(&bar[XB_TOPGEN]) == tg, bar);
            __builtin_amdgcn_fence(__ATOMIC_ACQUIRE, "agent");
            xb_add(&bar[XB_XGEN(b.x)], 1u);
            asm volatile("s_waitcnt vmcnt(0)" ::: "memory");
        } else {
            XB_SPIN(xb_ld(&bar[XB_XGEN(b.x)]) == gen, bar);
            __builtin_amdgcn_fence(__ATOMIC_ACQUIRE, "agent");
            asm volatile("s_waitcnt vmcnt(0)" ::: "memory");
        }
    }
    __syncthreads();
}


struct Frame { LAS unsigned char* lds; int tid, lane, wave, G, bid; };

#define LBAR() do { asm volatile("s_waitcnt lgkmcnt(0)" ::: "memory"); __builtin_amdgcn_s_barrier(); asm volatile("" ::: "memory"); } while (0)
__device__ __forceinline__ int wq_next(gu32* ctr, volatile LAS unsigned* slot, int tid) {
    LBAR();
    if (tid == 0) *slot = __hip_atomic_fetch_add(ctr, 1u, RLX_AGENT);
    LBAR();
    return (int)*slot;
}

__device__ __forceinline__ void p0_transpose_item(const float* W, int K, int N, bf16* WT, int mode, LAS float* scr, int item, int lane, const float* kscale = nullptr) {
    const int nblk = N / 32, kb = item / nblk, nb = item % nblk, k0 = 64 * kb, n0 = 32 * nb;
    const int rb = (mode == 0 || mode == 3 || mode == 4) ? n0 : ((n0 >> 7) * 256 + (n0 & 127) + (mode == 2 ? 128 : 0));
    float wv[32];
#pragma unroll
    for (int i = 0; i < 32; ++i) wv[i] = W[(size_t)(k0 + 2 * i + (lane >> 5)) * N + n0 + (lane & 31)];
#pragma unroll
    for (int i = 0; i < 32; ++i) scr[(2 * i + (lane >> 5)) * 33 + (lane & 31)] = wv[i];
    LDS_WAIT(); asm volatile("" ::: "memory");
    const int c = lane & 7;
    f32x4 ks0 = (f32x4){1.f, 1.f, 1.f, 1.f}, ks1 = ks0; if (kscale) { ks0 = *(const f32x4*)(kscale + k0 + 8 * c); ks1 = *(const f32x4*)(kscale + k0 + 8 * c + 4); }
#pragma unroll
    for (int j = 0; j < 4; ++j) { const int n = (lane >> 3) + 8 * j; const LAS float* s = scr + (8 * c) * 33 + n;
        u32x4 o; o.x = cvtpk(s[0 * 33] * ks0.x, s[1 * 33] * ks0.y); o.y = cvtpk(s[2 * 33] * ks0.z, s[3 * 33] * ks0.w); o.z = cvtpk(s[4 * 33] * ks1.x, s[5 * 33] * ks1.y); o.w = cvtpk(s[6 * 33] * ks1.z, s[7 * 33] * ks1.w);
        const int k0d = (mode == 4) ? ((k0 + 2048) & 4095) : k0;
        const size_t dst = (mode == 3) ? ((size_t)(((rb + n) >> 8) * (K >> 6) + kb) * 256 + ((rb + n) & 255)) * 64 + 8 * c : (size_t)(rb + n) * K + k0d + 8 * c;
        *(u32x4*)(WT + dst) = o; }
    LDS_WAIT(); asm volatile("" ::: "memory");
}
__device__ __forceinline__ void rms_regs_to_bf16(const f32x4 (&v)[16], const float* w, bf16* orow, int lane) {
    float s = 0.f;
#pragma unroll
    for (int j = 0; j < 16; ++j) s += (v[j].x * v[j].x + v[j].y * v[j].y) + (v[j].z * v[j].z + v[j].w * v[j].w);
    const float rstd = 1.0f / sqrtf(wave_sum(s) * (1.0f / DM) + EPS);
    const f32x4* wr = (const f32x4*)w + 2 * lane; u32x4* o16 = (u32x4*)orow + lane;
#pragma unroll
    for (int j = 0; j < 8; ++j) { const f32x4 w0 = wr[128 * j], w1 = wr[128 * j + 1]; const f32x4 a = v[2 * j], b = v[2 * j + 1]; u32x4 o;
        o.x = cvtpk(a.x * rstd * w0.x, a.y * rstd * w0.y); o.y = cvtpk(a.z * rstd * w0.z, a.w * rstd * w0.w); o.z = cvtpk(b.x * rstd * w1.x, b.y * rstd * w1.y); o.w = cvtpk(b.z * rstd * w1.z, b.w * rstd * w1.w); o16[64 * j] = o; }
}
__device__ __forceinline__ void rms_row_to_bf16(const float* xrow, const float* w, bf16* orow, int lane) {
    const f32x4* xr = (const f32x4*)xrow + 2 * lane; f32x4 v[16];
#pragma unroll
    for (int j = 0; j < 8; ++j) { v[2 * j] = xr[128 * j]; v[2 * j + 1] = xr[128 * j + 1]; }
    rms_regs_to_bf16(v, w, orow, lane);
}
constexpr int I_1 = (DM / 64) * (9248 / 32), I_2 = (DM / 64) * (DM / 32), I_3 = (DM / 64) * (DFF / 32), I_4 = (DFF / 64) * (DM / 32);
template <int WHICH> __device__ __forceinline__ void convert_weights(const Frame& F, int gw, int ngw) {
    LAS float* scr = (LAS float*)(F.lds + RING_OFF + F.wave * 16384);
    constexpr int NIT = WHICH == 0 ? I_1 + I_2 : (WHICH == 3 ? 2 * I_3 : I_4);
    for (int it = gw; it < NIT; it += ngw) {
        if (WHICH == 0) { if (it < I_1) p0_transpose_item(P_w_in, DM, 9248, P_W1, 0, scr, it, F.lane); else p0_transpose_item(P_w_out, DM, DM, P_W2, 4, scr, it - I_1, F.lane); }
        else if (WHICH == 3) { if (it < I_3) p0_transpose_item(P_w_gate, DM, DFF, P_W3, 1, scr, it, F.lane, P_ffn_nw); else p0_transpose_item(P_w_up, DM, DFF, P_W3, 2, scr, it - I_3, F.lane, P_ffn_nw); }
        else p0_transpose_item(P_w_down, DFF, DM, P_W4, 0, scr, it, F.lane);
    }
}
template <int WHICH> __device__ __forceinline__ void convert_weights_dyn(const Frame& F, gu32* ctr) {
    LAS float* scr = (LAS float*)(F.lds + RING_OFF + F.wave * 16384);
    constexpr int NIT = WHICH == 3 ? 2 * I_3 : I_4;
    for (;;) {
        unsigned v = 0u; if (F.lane == 0) v = __hip_atomic_fetch_add(ctr, 8u, RLX_AGENT);
        const int it0 = (int)__builtin_amdgcn_readfirstlane(v); if (it0 >= NIT) break;
#pragma unroll 1
        for (int k = 0; k < 8; ++k) { const int it = it0 + k; if (it >= NIT) break;
            if (WHICH == 3) { if (it < I_3) p0_transpose_item(P_w_gate, DM, DFF, P_W3, 1, scr, it, F.lane, P_ffn_nw); else p0_transpose_item(P_w_up, DM, DFF, P_W3, 2, scr, it - I_3, F.lane, P_ffn_nw); }
            else p0_transpose_item(P_w_down, DFF, DM, P_W4, 0, scr, it, F.lane); }
    }
}
template <int WHICH> __device__ __forceinline__ void tail_filler(const Frame& F, int nunits) {
    const int extra = nunits % F.G; const int first = extra, nhelp = F.G - extra;
    if (F.bid >= first) convert_weights<WHICH>(F, (F.bid - first) * NWAVES + F.wave, nhelp * NWAVES);
}
__device__ __forceinline__ void p0_prologue(const Frame& F, const Ptrs& P) {
    const int gw = F.bid * NWAVES + F.wave, NGW = F.G * NWAVES;
    convert_weights<0>(F, gw, NGW);
    for (int m = gw; m < M; m += NGW) { const float* xr = (m < MP) ? P_x_prompt + (size_t)m * DM : P_x_sample + (size_t)(m - MP) * DM; rms_row_to_bf16(xr, P_mix_nw, P_XN + (size_t)m * DM, F.lane); }
}

#ifdef PROBE_A
#ifndef PROBE_MULT
#define PROBE_MULT 8
#endif
#ifndef PROBE_BID
#define PROBE_BID 0
#endif
#define STAMP(i) do { if (F.bid == PROBE_BID && F.tid == 0 && ((i) == PROBE_A || (i) == PROBE_B)) { const unsigned long long t_ = __builtin_amdgcn_s_memrealtime(); volatile LAS unsigned* m_ = (volatile LAS unsigned*)(F.lds + MISC_OFF) + ((i) == PROBE_A ? 16 : 18); m_[0] = (unsigned)t_; m_[1] = (unsigned)(t_ >> 32); } } while (0)
#else
#define STAMP(i) do { } while (0)
#endif
#ifndef NREP_P0
#define NREP_P0 1
#endif
#ifndef NREP_MIX
#define NREP_MIX 1
#endif
#ifndef MIXDUP_A
#define MIXDUP_A 1
#endif
#ifndef MIXDUP_B
#define MIXDUP_B 1
#endif
#ifndef MIXDUP_C
#define MIXDUP_C 1
#endif
#ifndef MIXDUP_D
#define MIXDUP_D 1
#endif
#if NREP_MIX > 1
#define SSQ_REP_OFF (*(volatile LAS unsigned*)(F.lds + MISC_OFF + 20))
#else
#define SSQ_REP_OFF 0
#endif
constexpr int KS = 272, VS = 320;
__device__ __forceinline__ int t5_bucket(int n) { if (n < 16) return n; const float v = logf((float)n / 16.0f) / 2.0794415f * 16.0f; const int l = 16 + (int)v; return l < 31 ? l : 31; }

template <int ND> __device__ __forceinline__ void attn_task(const LAS unsigned char* Kl, const LAS unsigned char* Vl, int kt0, const bf16x8 (&qf)[8], int d0, int jmin, const LAS float* tb, float sink2, bf16* outp, int lane, int db) {
    const int q = lane & 31, hi = lane >> 5;
    asm volatile("" : "+v"(d0));
    f32x16 st[5];
#pragma unroll
    for (int t = 0; t < 5; ++t) {
        f32x16 a; for (int i = 0; i < 16; ++i) a[i] = 0.f;
        const LAS unsigned char* kp = Kl + ((kt0 + t) * 32 + q) * KS + hi * 16;
        bf16x8 kfr[8];
#pragma unroll
        for (int ks = 0; ks < 8; ++ks) kfr[ks] = *(const LAS bf16x8*)(kp + ks * 32);
#pragma unroll
        for (int ks = 0; ks < 8; ++ks) a = MFMA32(kfr[ks], qf[ks], a);
        st[t] = a; __builtin_amdgcn_sched_barrier(0);
    }
    float mx = sink2;
#pragma unroll
    for (int t = 0; t < 5; ++t)
        {   float bv[16];
#pragma unroll
            for (int r = 0; r < 16; ++r) bv[r] = tb[(d0 - 32 * t - crow(r, hi)) & 127];
            asm volatile("" : "+v"(bv[0]), "+v"(bv[1]), "+v"(bv[2]), "+v"(bv[3]), "+v"(bv[4]), "+v"(bv[5]), "+v"(bv[6]), "+v"(bv[7]), "+v"(bv[8]), "+v"(bv[9]), "+v"(bv[10]), "+v"(bv[11]), "+v"(bv[12]), "+v"(bv[13]), "+v"(bv[14]), "+v"(bv[15]));
            if (t >= 1 && t <= 3 && jmin <= 32) {
#pragma unroll
                for (int r = 0; r < 16; ++r) { const float s = st[t][r] + bv[r]; st[t][r] = s; mx = fmaxf(mx, s); }
            } else {
#pragma unroll
            for (int r = 0; r < 16; ++r) { const int jj = 32 * t + crow(r, hi); const int dist = d0 - jj; const bool ok = ((unsigned)dist < 128u) && (jj >= jmin);
                const float s = ok ? st[t][r] + bv[r] : -__builtin_inff(); st[t][r] = s; mx = fmaxf(mx, s); } } }
    mx = fmaxf(mx, __shfl_xor(mx, 32));
    float l = 0.f;
#pragma unroll
    for (int t = 0; t < 5; ++t)
#pragma unroll
        for (int r = 0; r < 16; ++r) { const float p = __builtin_amdgcn_exp2f(st[t][r] - mx); st[t][r] = p; l += p; }
    l += __shfl_xor(l, 32); l += __builtin_amdgcn_exp2f(sink2 - mx);
    const float inv = 1.0f / l;
    f32x16 ot[ND];
#pragma unroll
    for (int d = 0; d < ND; ++d) for (int i = 0; i < 16; ++i) ot[d][i] = 0.f;
    const int g4 = lane >> 4, i16 = lane & 15;
    const LAS unsigned char* vp = Vl + (kt0 * 32 + 4 * hi + (i16 >> 2)) * VS + ((g4 & 1) * 16 + (i16 & 3) * 4) * 2;
#pragma unroll
    for (int t = 0; t < 5; ++t)
#pragma unroll
        for (int s2 = 0; s2 < 2; ++s2) { const bf16x8 pf = pack_step(st[t], s2);
            bf16x8 vfr[ND];
#pragma unroll
            for (int d = 0; d < ND; ++d) { const LAS unsigned char* a = vp + (t * 32 + s2 * 16) * VS + (db + d) * 64; vfr[d] = cat4(vtr(a), vtr(a + 8 * VS)); }
#pragma unroll
            for (int d = 0; d < ND; ++d) ot[d] = MFMA32(vfr[d], pf, ot[d]);
            __builtin_amdgcn_sched_barrier(0); }
#pragma unroll
    for (int d = 0; d < ND; ++d)
#pragma unroll
        for (int r4 = 0; r4 < 4; ++r4) { u32x2 w; w.x = cvtpk(ot[d][4 * r4] * inv, ot[d][4 * r4 + 1] * inv); w.y = cvtpk(ot[d][4 * r4 + 2] * inv, ot[d][4 * r4 + 3] * inv);
            *(u32x2*)(outp + 32 * (db + d) + 8 * r4 + 4 * hi) = w; }
}
__device__ __forceinline__ void load_q(const bf16* qp, const float* qnw, int hi, bf16x8 (&qf)[8]) {
    u32x4 qw[8]; float ss = 0.f;
#pragma unroll
    for (int ks = 0; ks < 8; ++ks) { qw[ks] = *(const u32x4*)(qp + 16 * ks); float f[8]; unpack8(qw[ks], f);
#pragma unroll
        for (int i = 0; i < 8; ++i) ss += f[i] * f[i]; }
    ss += __shfl_xor(ss, 32);
    const float sc = (1.0f / sqrtf(ss * (1.0f / 128.0f) + EPS)) * 0.08838834764831845f * LOG2E;
#pragma unroll
    for (int ks = 0; ks < 8; ++ks) { float f[8]; unpack8(qw[ks], f); const f32x4 w0 = *(const f32x4*)(qnw + 16 * ks + 8 * hi), w1 = *(const f32x4*)(qnw + 16 * ks + 8 * hi + 4);
        f[0] *= sc * w0.x; f[1] *= sc * w0.y; f[2] *= sc * w0.z; f[3] *= sc * w0.w; f[4] *= sc * w1.x; f[5] *= sc * w1.y; f[6] *= sc * w1.z; f[7] *= sc * w1.w;
        qf[ks] = __builtin_bit_cast(bf16x8, pack8(f)); }
}
__device__ __forceinline__ float red16(float v) { v += __shfl_xor(v, 1); v += __shfl_xor(v, 2); v += __shfl_xor(v, 4); v += __shfl_xor(v, 8); return v; }

__device__ __forceinline__ void attn_prompt_unit(const Frame& F, const Ptrs& P, int unit) {
    const int kvh = unit & 3, qb = (unit >> 2) & 31, b = unit >> 7, t0 = 64 * qb, rowb = b * SEQ;
    LAS unsigned char* Kl = F.lds + RING_OFF; LAS unsigned char* Vl = Kl + 192 * KS;
    const f32x4 knw0 = *(const f32x4*)(P_k_nw + (F.tid & 15) * 8), knw1 = *(const f32x4*)(P_k_nw + (F.tid & 15) * 8 + 4);
#pragma unroll 1
    for (int hb = 0; hb < 2; ++hb) {
    u32x4 kwv[3], vwv[3];
#pragma unroll
    for (int it = 0; it < 3; ++it) { const int task = F.tid + 512 * (it + 3 * hb), r = task >> 4, ch = task & 15, pos = t0 - 128 + r;
        kwv[it] = (u32x4){0u, 0u, 0u, 0u}; vwv[it] = kwv[it];
        if (pos >= 0) { const bf16* pr = P_PROJ + (size_t)(rowb + pos) * LDP + kvh * 128 + ch * 8; kwv[it] = *(const u32x4*)(pr + C_K); vwv[it] = *(const u32x4*)(pr + C_V); } }
#pragma unroll
    for (int it = 0; it < 3; ++it) {
        const int task = F.tid + 512 * (it + 3 * hb), r = task >> 4, ch = task & 15, pos = t0 - 128 + r;
        const u32x4 vw = vwv[it];
        float kf[8]; unpack8(kwv[it], kf); float ss = 0.f;
#pragma unroll
        for (int i = 0; i < 8; ++i) ss += kf[i] * kf[i];
        ss = red16(ss);
        const float rstd = 1.0f / sqrtf(ss * (1.0f / 128.0f) + EPS);
        kf[0] *= rstd * knw0.x; kf[1] *= rstd * knw0.y; kf[2] *= rstd * knw0.z; kf[3] *= rstd * knw0.w; kf[4] *= rstd * knw1.x; kf[5] *= rstd * knw1.y; kf[6] *= rstd * knw1.z; kf[7] *= rstd * knw1.w;
        *(LAS u32x4*)(Kl + r * KS + ch * 16) = pack8(kf);
        *(LAS u32x4*)(Vl + r * VS + ch * 16) = vw;
        if (t0 >= SEQ - 128 && r >= 128) {
            const size_t o = (((size_t)b * 128 + (pos - (SEQ - 128))) * 4 + kvh) * 128 + ch * 8; float vf[8]; unpack8(vw, vf);
            *(f32x4*)(P_out + O_PK + o) = (f32x4){kf[0], kf[1], kf[2], kf[3]}; *(f32x4*)(P_out + O_PK + o + 4) = (f32x4){kf[4], kf[5], kf[6], kf[7]};
            *(f32x4*)(P_out + O_PV + o) = (f32x4){vf[0], vf[1], vf[2], vf[3]}; *(f32x4*)(P_out + O_PV + o + 4) = (f32x4){vf[4], vf[5], vf[6], vf[7]};
        }
    }
    }
    __builtin_amdgcn_sched_barrier(0);
    const int q = F.lane & 31, hi = F.lane >> 5, g = F.wave >> 1, sub = F.wave & 1, head = kvh * 4 + g;
    const int row = rowb + t0 + 32 * sub + q;
    bf16x8 qf[8]; load_q(P_PROJ + (size_t)row * LDP + C_Q + head * 128 + 8 * hi, P_q_nw, hi, qf);
    LBAR();
    attn_task<4>(Kl, Vl, sub, qf, 128 + q, 128 - t0 - 32 * sub, (const LAS float*)(F.lds + TB_OFF) + head * 128, P_sinks[head] * LOG2E, P_MIX + (size_t)row * DM + 2048 + head * 128, F.lane, 0);
}
__device__ __forceinline__ void attn_sample_unit(const Frame& F, const Ptrs& P, int unit) {
    const int kvh = unit & 3, b = unit >> 2;
    LAS unsigned char* Kl = F.lds + RING_OFF; LAS unsigned char* Vl = Kl + 160 * KS;
    f32x4 ld[5][4];
#pragma unroll
    for (int it = 0; it < 5; ++it) { const int task = F.tid + 512 * it, r = task >> 4, ch = task & 15;
#pragma unroll
        for (int j = 0; j < 4; ++j) ld[it][j] = (f32x4){0.f, 0.f, 0.f, 0.f};
        if (r < 128) { const size_t o = (((size_t)b * 128 + r) * 4 + kvh) * 128 + ch * 8;
            ld[it][0] = *(const f32x4*)(P_st_k + o); ld[it][1] = *(const f32x4*)(P_st_k + o + 4); ld[it][2] = *(const f32x4*)(P_st_v + o); ld[it][3] = *(const f32x4*)(P_st_v + o + 4); }
        else if (r < 136) { const bf16* pr = P_PROJ + (size_t)(MP + b * 8 + (r - 128)) * LDP + kvh * 128 + ch * 8; float kf[8], vf[8]; unpack8(*(const u32x4*)(pr + C_K), kf); unpack8(*(const u32x4*)(pr + C_V), vf);
            ld[it][0] = (f32x4){kf[0], kf[1], kf[2], kf[3]}; ld[it][1] = (f32x4){kf[4], kf[5], kf[6], kf[7]}; ld[it][2] = (f32x4){vf[0], vf[1], vf[2], vf[3]}; ld[it][3] = (f32x4){vf[4], vf[5], vf[6], vf[7]}; } }
    const f32x4 knw0 = *(const f32x4*)(P_k_nw + (F.tid & 15) * 8), knw1 = *(const f32x4*)(P_k_nw + (F.tid & 15) * 8 + 4);
#pragma unroll
    for (int it = 0; it < 5; ++it) {
        const int task = F.tid + 512 * it, r = task >> 4, ch = task & 15;
        f32x4 k0 = ld[it][0], k1 = ld[it][1]; const f32x4 v0 = ld[it][2], v1 = ld[it][3];
        if (r >= 8 && r < 128) { const size_t o2 = (((size_t)b * 128 + (r - 8)) * 4 + kvh) * 128 + ch * 8; *(f32x4*)(P_out + O_SK + o2) = k0; *(f32x4*)(P_out + O_SK + o2 + 4) = k1; *(f32x4*)(P_out + O_SV + o2) = v0; *(f32x4*)(P_out + O_SV + o2 + 4) = v1; }
        float ss = (k0.x * k0.x + k0.y * k0.y) + (k0.z * k0.z + k0.w * k0.w) + (k1.x * k1.x + k1.y * k1.y) + (k1.z * k1.z + k1.w * k1.w);
        ss = red16(ss);
        if (r >= 128 && r < 136) {
            const float rstd = 1.0f / sqrtf(ss * (1.0f / 128.0f) + EPS);
            k0 = k0 * rstd * knw0; k1 = k1 * rstd * knw1;
            const size_t o2 = (((size_t)b * 128 + 120 + (r - 128)) * 4 + kvh) * 128 + ch * 8;
            *(f32x4*)(P_out + O_SK + o2) = k0; *(f32x4*)(P_out + O_SK + o2 + 4) = k1; *(f32x4*)(P_out + O_SV + o2) = v0; *(f32x4*)(P_out + O_SV + o2 + 4) = v1;
        }
        u32x4 kw, vw; kw.x = cvtpk(k0.x, k0.y); kw.y = cvtpk(k0.z, k0.w); kw.z = cvtpk(k1.x, k1.y); kw.w = cvtpk(k1.z, k1.w); vw.x = cvtpk(v0.x, v0.y); vw.y = cvtpk(v0.z, v0.w); vw.z = cvtpk(v1.x, v1.y); vw.w = cvtpk(v1.z, v1.w);
        *(LAS u32x4*)(Kl + r * KS + ch * 16) = kw;
        *(LAS u32x4*)(Vl + r * VS + ch * 16) = vw;
    }
    LBAR();
    if (F.wave == 0) {
        const int q = F.lane & 31, hi = F.lane >> 5, g = q >> 3, i = q & 7, head = kvh * 4 + g, row = MP + b * 8 + i;
        bf16x8 qf[8]; load_q(P_PROJ + (size_t)row * LDP + C_Q + head * 128 + 8 * hi, P_q_nw, hi, qf);
        attn_task<4>(Kl, Vl, 0, qf, 128 + i, 0, (const LAS float*)(F.lds + TB_OFF) + head * 128, P_sinks[head] * LOG2E, P_MIX + (size_t)row * DM + 2048 + head * 128, F.lane, 0);
    }
}

__device__ __forceinline__ void store8f(float* p, const u32x4 w) { float f[8]; unpack8(w, f); *(f32x4*)p = (f32x4){f[0], f[1], f[2], f[3]}; *(f32x4*)(p + 4) = (f32x4){f[4], f[5], f[6], f[7]}; }
__device__ __forceinline__ void p2_conv_pass(const Frame& F, const Ptrs& P) {
    const int ntask = (M / 8) * 512; bf16* XB = (bf16*)(P_ws + WS_XBCC);
    for (int task = F.bid * 512 + F.tid; task < ntask; task += F.G * 512) {
        const int cc = task & 511, rb = task >> 9, ch = cc * 8, r0 = rb * 8;
        float w[5][8];
#pragma unroll
        for (int k = 0; k < 5; ++k) { const float* src = k < 4 ? P_conv_w + k * 4096 + ch : P_conv_b + ch; const f32x4 a = *(const f32x4*)src, c = *(const f32x4*)(src + 4);
            w[k][0] = a.x; w[k][1] = a.y; w[k][2] = a.z; w[k][3] = a.w; w[k][4] = c.x; w[k][5] = c.y; w[k][6] = c.z; w[k][7] = c.w; }
        float xp[11][8];
        const bf16* src = P_PROJ + (size_t)r0 * LDP + C_X + ch;
        u32x4 raw[8];
#pragma unroll
        for (int t = 0; t < 8; ++t) { raw[t] = *(const u32x4*)(src + (size_t)t * LDP); unpack8(raw[t], xp[3 + t]); }
        if (r0 < MP) {
            if ((r0 & (SEQ - 1)) != 0) {
#pragma unroll
                for (int j = 0; j < 3; ++j) unpack8(*(const u32x4*)(src - (size_t)(3 - j) * LDP), xp[j]); }
            else {
#pragma unroll
                for (int j = 0; j < 3; ++j)
#pragma unroll
                    for (int i = 0; i < 8; ++i) xp[j][i] = 0.f; }
            if ((r0 & (SEQ - 1)) == SEQ - 8) {
#pragma unroll
                for (int j = 0; j < 3; ++j) store8f(P_out + O_PCONV + ((size_t)(r0 >> 11) * 3 + j) * 4096 + ch, raw[5 + j]); }
        } else { const int bs = (r0 - MP) >> 3;
#pragma unroll
            for (int j = 0; j < 3; ++j) { const f32x4 a = *(const f32x4*)(P_st_conv + ((size_t)bs * 3 + j) * 4096 + ch), c = *(const f32x4*)(P_st_conv + ((size_t)bs * 3 + j) * 4096 + ch + 4);
                xp[j][0] = a.x; xp[j][1] = a.y; xp[j][2] = a.z; xp[j][3] = a.w; xp[j][4] = c.x; xp[j][5] = c.y; xp[j][6] = c.z; xp[j][7] = c.w; }
#pragma unroll
            for (int j = 0; j < 3; ++j) store8f(P_out + O_SCONV + ((size_t)bs * 3 + j) * 4096 + ch, raw[5 + j]);
        }
#pragma unroll
        for (int t = 0; t < 8; ++t) { float o[8];
#pragma unroll
            for (int i = 0; i < 8; ++i) o[i] = silu_f(w[4][i] + w[0][i] * xp[t][i] + w[1][i] * xp[t + 1][i] + w[2][i] * xp[t + 2][i] + w[3][i] * xp[t + 3][i]);
            *(u32x4*)(XB + (size_t)(r0 + t) * 4096 + ch) = pack8(o); }
    }
}

constexpr int XSTR = 144, BSTR = 272;
constexpr int L_XS = 0, L_XW = 18432, L_BS = 36864, L_CS = 71680, L_HS = 106496, L_ACS = 123904;

__device__ __forceinline__ void ssd_prompt_unit(const Frame& F, const Ptrs& P, int unit) {
    const int h = unit & 31, b = unit >> 5, grp = h >> 2, rowb0 = b * SEQ;
    LAS unsigned char* L = F.lds + RING_OFF;
    LAS float* ACS2 = (LAS float*)(L + L_ACS); LAS float* DTV2 = ACS2 + 256;
    const bf16* XB = (const bf16*)(P_ws + WS_XBCC);
    for (int i = F.tid; i < 64 * BSTR / 4; i += 512) ((LAS unsigned*)(L + L_HS))[i] = 0u;
    f32x16 hacc; for (int i = 0; i < 16; ++i) hacc[i] = 0.f;
    const float Ah = -__expf(P_A_log[h]), Dh = P_Dv[h], dtb = P_dt_bias[h];
    u32x4 rb[4], rc[4], rx[2]; u32x2 zq[4]; unsigned short dr0 = 0, dr1 = 0;
    u32x2 ow[4]; float ossq = 0.f;
#pragma unroll
    for (int i = 0; i < 4; ++i) ow[i] = (u32x2){0u, 0u};
#define SSD_ISSUE(c) do { int t_ = F.tid; asm volatile("" : "+v"(t_)); \
        const bf16* pB_ = XB + (size_t)(rowb0 + 128 * (c) + (t_ >> 4)) * 4096 + 2048 + grp * 128 + (t_ & 15) * 8; const bf16* pX_ = XB + (size_t)(rowb0 + 128 * (c) + (t_ >> 3)) * 4096 + h * 64 + (t_ & 7) * 8; \
        _Pragma("unroll") for (int j_ = 0; j_ < 4; ++j_) { rb[j_] = *(const u32x4*)(pB_ + (size_t)(32 * j_) * 4096); rc[j_] = *(const u32x4*)(pB_ + (size_t)(32 * j_) * 4096 + 1024); } \
        _Pragma("unroll") for (int j_ = 0; j_ < 2; ++j_) rx[j_] = *(const u32x4*)(pX_ + (size_t)(64 * j_) * 4096); \
        { const int ln_ = t_ & 63; const bf16* zp_ = P_PROJ + (size_t)(rowb0 + 128 * (c) + 32 * (F.wave >> 1) + (ln_ & 31)) * LDP + C_Z + h * 64 + 32 * (F.wave & 1) + 4 * (ln_ >> 5); \
          _Pragma("unroll") for (int r4_ = 0; r4_ < 4; ++r4_) zq[r4_] = *(const u32x2*)(zp_ + 8 * r4_); } \
        if (F.wave == 0) { const bf16* pD_ = P_PROJ + (size_t)(rowb0 + 128 * (c) + 2 * (t_ & 63)) * LDP + C_DT + h; dr0 = pD_[0]; dr1 = pD_[LDP]; } } while (0)
#define SSD_SCAN_STEP(ctrl, rmask, bctl) s_ += __builtin_bit_cast(float, __builtin_amdgcn_update_dpp(0, __builtin_bit_cast(int, s_), ctrl, rmask, 0xf, bctl))
#define SSD_DT(buf) do { if (F.wave == 0) { int ln_ = F.lane; asm volatile("" : "+v"(ln_)); const int ta_ = 2 * ln_; const float dv0_ = softplus_f(bf2f(dr0) + dtb), dv1_ = softplus_f(bf2f(dr1) + dtb); const float a1_ = dv1_ * Ah; float s_ = dv0_ * Ah + a1_; \
        SSD_SCAN_STEP(0x111, 0xf, true); SSD_SCAN_STEP(0x112, 0xf, true); SSD_SCAN_STEP(0x114, 0xf, true); SSD_SCAN_STEP(0x118, 0xf, true); SSD_SCAN_STEP(0x142, 0xa, false); SSD_SCAN_STEP(0x143, 0xc, false); \
        ACS2[(buf) * 128 + ta_] = s_ - a1_; ACS2[(buf) * 128 + ta_ + 1] = s_; DTV2[(buf) * 128 + ta_] = dv0_; DTV2[(buf) * 128 + ta_ + 1] = dv1_; } } while (0)
    SSD_ISSUE(0);
    SSD_DT(0);
    LBAR();
    for (int c = 0; c < 16; ++c) {
        const int rowb = rowb0 + 128 * c; const LAS float* ACS = ACS2 + (c & 1) * 128; const LAS float* DTV = DTV2 + (c & 1) * 128;
        const float acs_end = ACS[127];
        if (c == 8) STAMP(30);
        {
            int t_ = F.tid; asm volatile("" : "+v"(t_)); const int bcc = t_ & 15, br = t_ >> 4, xcc = t_ & 7, xr = t_ >> 3;
#pragma unroll
            for (int j = 0; j < 4; ++j) { *(LAS u32x4*)(L + L_BS + (br + 32 * j) * BSTR + bcc * 16) = rb[j]; *(LAS u32x4*)(L + L_CS + (br + 32 * j) * BSTR + bcc * 16) = rc[j]; }
#pragma unroll
            for (int j = 0; j < 2; ++j) { const int l = xr + 64 * j; *(LAS u32x4*)(L + L_XS + l * XSTR + xcc * 16) = rx[j];
                const float sc = DTV[l] * __expf(acs_end - ACS[l]); float f[8]; unpack8(rx[j], f);
#pragma unroll
                for (int i = 0; i < 8; ++i) f[i] *= sc;
                *(LAS u32x4*)(L + L_XW + l * XSTR + xcc * 16) = pack8(f); }
        }
        __builtin_amdgcn_sched_barrier(0);
        int ln = F.lane; asm volatile("" : "+v"(ln)); const int q = ln & 31, hi = ln >> 5, g4 = ln >> 4, i16 = ln & 15;
        const int pt = F.wave & 1, lt = F.wave >> 1, l = 32 * lt + q, row = rowb + l;
        u32x2 zw[4];
#pragma unroll
        for (int r4 = 0; r4 < 4; ++r4) zw[r4] = zq[r4];
        if (c > 0) { const int prow_ = row - 128;
#pragma unroll
            for (int r4 = 0; r4 < 4; ++r4) *(u32x2*)(P_MIX + (size_t)prow_ * DM + h * 64 + 32 * pt + 8 * r4 + 4 * hi) = ow[r4];
            if (hi == 0) atomicAdd(P_ssq + SSQ_REP_OFF + prow_, ossq); }
        if (c < 15) SSD_ISSUE(c + 1);
        LBAR();
        if (c == 8) STAMP(31);
        {
            bf16x8 cf[8];
#pragma unroll
            for (int ks = 0; ks < 8; ++ks) cf[ks] = *(const LAS bf16x8*)(L + L_CS + l * BSTR + ks * 32 + hi * 16);
            f32x16 y; for (int i = 0; i < 16; ++i) y[i] = 0.f;
            if (c > 0) {
                bf16x8 hfr[8];
#pragma unroll
                for (int ks = 0; ks < 8; ++ks) hfr[ks] = *(const LAS bf16x8*)(L + L_HS + (32 * pt + q) * BSTR + ks * 32 + hi * 16);
#pragma unroll
                for (int ks = 0; ks < 8; ++ks) y = MFMA32(hfr[ks], cf[ks], y);
            }
            const float acs_l = ACS[l], ea = __expf(acs_l);
#pragma unroll
            for (int i = 0; i < 16; ++i) y[i] *= ea;
#pragma unroll 1
            for (int st = 0; st <= lt; ++st) {
                f32x16 g; for (int i = 0; i < 16; ++i) g[i] = 0.f;
                bf16x8 bfr[8], xfr[2];
#pragma unroll
                for (int ks = 0; ks < 8; ++ks) bfr[ks] = *(const LAS bf16x8*)(L + L_BS + (32 * st + q) * BSTR + ks * 32 + hi * 16);
#pragma unroll
                for (int s2 = 0; s2 < 2; ++s2) { const LAS unsigned char* a = L + L_XS + (32 * st + 16 * s2 + 4 * hi + (i16 >> 2)) * XSTR + (32 * pt + (g4 & 1) * 16 + (i16 & 3) * 4) * 2; xfr[s2] = cat4(vtr(a), vtr(a + 8 * XSTR)); }
#pragma unroll
                for (int ks = 0; ks < 8; ++ks) g = MFMA32(bfr[ks], cf[ks], g);
#pragma unroll
                for (int r4 = 0; r4 < 4; ++r4) {
                    const f32x4 a4 = *(const LAS f32x4*)(ACS + 32 * st + 8 * r4 + 4 * hi), d4 = *(const LAS f32x4*)(DTV + 32 * st + 8 * r4 + 4 * hi);
#pragma unroll
                    for (int e = 0; e < 4; ++e) { const int s = 32 * st + 8 * r4 + 4 * hi + e; const float v = g[4 * r4 + e] * __expf(fminf(acs_l - a4[e], 0.f)) * d4[e]; g[4 * r4 + e] = (s <= l) ? v : 0.f; } }
#pragma unroll
                for (int s2 = 0; s2 < 2; ++s2) { const bf16x8 pf = pack_step(g, s2); y = MFMA32(xfr[s2], pf, y); }
                __builtin_amdgcn_sched_barrier(0);
            }
            float ssq = 0.f;
#pragma unroll
            for (int r4 = 0; r4 < 4; ++r4) { const u32x2 xw = *(const LAS u32x2*)(L + L_XS + l * XSTR + (32 * pt + 8 * r4 + 4 * hi) * 2);
                const f32x4 nw = *(const f32x4*)(P_ssd_nw + h * 64 + 32 * pt + 8 * r4 + 4 * hi);
                const float z0 = bflo(zw[r4].x), z1 = bfhi(zw[r4].x), z2 = bflo(zw[r4].y), z3 = bfhi(zw[r4].y);
                const float g0 = (y[4 * r4] + Dh * bflo(xw.x)) * silu_f(z0), g1 = (y[4 * r4 + 1] + Dh * bfhi(xw.x)) * silu_f(z1), g2 = (y[4 * r4 + 2] + Dh * bflo(xw.y)) * silu_f(z2), g3 = (y[4 * r4 + 3] + Dh * bfhi(xw.y)) * silu_f(z3);
                ssq += (g0 * g0 + g1 * g1) + (g2 * g2 + g3 * g3);
                ow[r4].x = cvtpk(g0 * nw.x, g1 * nw.y); ow[r4].y = cvtpk(g2 * nw.z, g3 * nw.w); }
            ssq += __shfl_xor(ssq, 32);
            ossq = ssq;
        }
        if (c == 8) STAMP(34);
        LBAR();
        if (c == 8) STAMP(32);
        {
            const int pt2 = F.wave & 1, nt = F.wave >> 1; const float eend = __expf(acs_end);
#pragma unroll
            for (int i = 0; i < 16; ++i) hacc[i] *= eend;
#pragma unroll
            for (int kb = 0; kb < 2; ++kb) { bf16x8 afr[4], bfr[4];
#pragma unroll
                for (int k4 = 0; k4 < 4; ++k4) { const int ks = 4 * kb + k4, srow = 16 * ks + 8 * hi + (i16 >> 2), cofs = ((g4 & 1) * 16 + (i16 & 3) * 4) * 2;
                    const LAS unsigned char* a = L + L_XW + srow * XSTR + 64 * pt2 + cofs; const LAS unsigned char* bp = L + L_BS + srow * BSTR + 64 * nt + cofs;
                    afr[k4] = cat4(vtr(a), vtr(a + 4 * XSTR)); bfr[k4] = cat4(vtr(bp), vtr(bp + 4 * BSTR)); }
#pragma unroll
                for (int k4 = 0; k4 < 4; ++k4) hacc = MFMA32(afr[k4], bfr[k4], hacc); }
#pragma unroll
            for (int r = 0; r < 16; ++r) *(LAS unsigned short*)(L + L_HS + (32 * pt2 + crow(r, hi)) * BSTR + (32 * nt + q) * 2) = (unsigned short)(cvtpk(hacc[r], 0.f) & 0xffffu);
            if (c < 15) SSD_DT((c + 1) & 1);
        }
        LBAR();
        if (c == 8) STAMP(33);
    }
#undef SSD_ISSUE
#undef SSD_DT
#undef SSD_SCAN_STEP
    {   const int ln = F.lane, q = ln & 31, hi = ln >> 5, pt = F.wave & 1, lt = F.wave >> 1, prow_ = rowb0 + 128 * 15 + 32 * lt + q;
#pragma unroll
        for (int r4 = 0; r4 < 4; ++r4) *(u32x2*)(P_MIX + (size_t)prow_ * DM + h * 64 + 32 * pt + 8 * r4 + 4 * hi) = ow[r4];
        if (hi == 0) atomicAdd(P_ssq + SSQ_REP_OFF + prow_, ossq); }
    {   const int pt = F.wave & 1, nt = F.wave >> 1, q = F.lane & 31, hi = F.lane >> 5;
#pragma unroll
        for (int r = 0; r < 16; ++r) P_out[O_PSSM + ((size_t)(b * 32 + h) * 64 + 32 * pt + crow(r, hi)) * 128 + 32 * nt + q] = hacc[r]; }
}

__device__ __forceinline__ void ssd_sample_unit(const Frame& F, const Ptrs& P, int unit) {
    const int grp = unit & 7, b = unit >> 3;
    STAMP(40);
    LAS float* XC = (LAS float*)(F.lds + RING_OFF); LAS float* BC = XC + 2048; LAS float* CC = BC + 1024; LAS float* ZC = CC + 1024; LAS float* DTVs = ZC + 2048; LAS float* ACSs = DTVs + 32;
    LAS float* SQL = ACSs + 32; LAS float* CBm = SQL + 32; LAS float* Gm = CBm + 64; LAS float* Wm = Gm + 256; LAS float* Em = Wm + 32;
    const int hh = F.wave >> 1, half = F.wave & 1, h = grp * 4 + hh, pl = F.lane & 31, hi = F.lane >> 5, p = 32 * half + pl;
    const size_t sofs = ((size_t)(b * 32 + h) * 64 + p) * 128 + 8 * hi;
    f32x4 hk[8][2];
#pragma unroll
    for (int ks = 0; ks < 8; ++ks) { hk[ks][0] = *(const f32x4*)(P_st_ssm + sofs + 16 * ks); hk[ks][1] = *(const f32x4*)(P_st_ssm + sofs + 16 * ks + 4); }
    if (F.tid < 8) SQL[F.tid] = 0.f;
    {   const int ci = F.tid; int ch, stride; LAS float* dst; const bf16* XB = (const bf16*)(P_ws + WS_XBCC);
        if (ci < 256) { ch = grp * 256 + ci; dst = XC + ci; stride = 256; } else if (ci < 384) { ch = 2048 + grp * 128 + (ci - 256); dst = BC + (ci - 256); stride = 128; } else { ch = 3072 + grp * 128 + (ci - 384); dst = CC + (ci - 384); stride = 128; }
#pragma unroll
        for (int t = 0; t < 8; ++t) dst[t * stride] = bf2f(XB[(size_t)(MP + b * 8 + t) * 4096 + ch]);
        if (ci < 256) {
#pragma unroll
            for (int t = 0; t < 8; ++t) ZC[t * 256 + ci] = bf2f(P_PROJ[(size_t)(MP + b * 8 + t) * LDP + C_Z + grp * 256 + ci]); }
    }
    if (F.tid < 32) { const int t = F.tid & 7, h2 = grp * 4 + (F.tid >> 3); DTVs[F.tid] = softplus_f(bf2f(P_PROJ[(size_t)(MP + b * 8 + t) * LDP + C_DT + h2]) + P_dt_bias[h2]); }
    LBAR();
    if (F.tid < 32) { const int t = F.tid & 7, h2 = grp * 4 + (F.tid >> 3); const float Ah = -__expf(P_A_log[h2]); float s = 0.f;
        for (int k = 0; k < 8; ++k) s += (k <= t) ? DTVs[(F.tid & ~7) + k] * Ah : 0.f;
        ACSs[F.tid] = s; }
    else if (F.wave == 1) {
        const int l = F.lane & 31, hq = F.lane >> 5, tr = l & 7; const float am = (l < 8) ? 1.0f : 0.0f;
        f32x16 cb; for (int i = 0; i < 16; ++i) cb[i] = 0.f;
#pragma unroll
        for (int ks = 0; ks < 8; ++ks) { const f32x4 c0 = *(const LAS f32x4*)(CC + tr * 128 + 16 * ks + 8 * hq) * am, c1 = *(const LAS f32x4*)(CC + tr * 128 + 16 * ks + 8 * hq + 4) * am;
            const f32x4 b0 = *(const LAS f32x4*)(BC + tr * 128 + 16 * ks + 8 * hq) * am, b1 = *(const LAS f32x4*)(BC + tr * 128 + 16 * ks + 8 * hq + 4) * am;
            u32x4 aw, bw; aw.x = cvtpk(c0.x, c0.y); aw.y = cvtpk(c0.z, c0.w); aw.z = cvtpk(c1.x, c1.y); aw.w = cvtpk(c1.z, c1.w); bw.x = cvtpk(b0.x, b0.y); bw.y = cvtpk(b0.z, b0.w); bw.z = cvtpk(b1.x, b1.y); bw.w = cvtpk(b1.z, b1.w);
            cb = MFMA32(__builtin_bit_cast(bf16x8, aw), __builtin_bit_cast(bf16x8, bw), cb); }
        if (l < 8) {
#pragma unroll
            for (int r = 0; r < 4; ++r) CBm[(4 * hq + r) * 8 + l] = cb[r]; } }
    LBAR();
    if (F.tid < 256) { const int h3 = F.tid >> 6, t = (F.tid >> 3) & 7, s2 = F.tid & 7;
        const float at = ACSs[h3 * 8 + t], as = ACSs[h3 * 8 + s2];
        Gm[F.tid] = (s2 <= t) ? CBm[t * 8 + s2] * __expf(at - as) * DTVs[h3 * 8 + s2] : 0.f;
        if (t == 7) Wm[h3 * 8 + s2] = __expf(at - as) * DTVs[h3 * 8 + s2];
        if (s2 == 0) Em[h3 * 8 + t] = __expf(at); }
    LBAR();
    STAMP(41);
    f32x16 yacc; for (int i = 0; i < 16; ++i) yacc[i] = 0.f;
    {   const int tr = pl & 7; const float am = (pl < 8) ? 1.0f : 0.0f;
#pragma unroll
        for (int ks = 0; ks < 8; ++ks) { const f32x4 c0 = *(const LAS f32x4*)(CC + tr * 128 + 16 * ks + 8 * hi) * am, c1 = *(const LAS f32x4*)(CC + tr * 128 + 16 * ks + 8 * hi + 4) * am;
            u32x4 aw, bw; aw.x = cvtpk(c0.x, c0.y); aw.y = cvtpk(c0.z, c0.w); aw.z = cvtpk(c1.x, c1.y); aw.w = cvtpk(c1.z, c1.w);
            bw.x = cvtpk(hk[ks][0].x, hk[ks][0].y); bw.y = cvtpk(hk[ks][0].z, hk[ks][0].w); bw.z = cvtpk(hk[ks][1].x, hk[ks][1].y); bw.w = cvtpk(hk[ks][1].z, hk[ks][1].w);
            yacc = MFMA32(__builtin_bit_cast(bf16x8, aw), __builtin_bit_cast(bf16x8, bw), yacc); } }
    float xs[8];
#pragma unroll
    for (int s2 = 0; s2 < 8; ++s2) xs[s2] = XC[s2 * 256 + hh * 64 + p];
    const float Dh = P_Dv[h], nw = P_ssd_nw[h * 64 + p];
    float sq[4];
#pragma unroll
    for (int r = 0; r < 4; ++r) { const int t = 4 * hi + r; float y = Em[hh * 8 + t] * yacc[r];
        const f32x4 g0 = *(const LAS f32x4*)(Gm + hh * 64 + t * 8), g1 = *(const LAS f32x4*)(Gm + hh * 64 + t * 8 + 4);
        y += (g0.x * xs[0] + g0.y * xs[1]) + (g0.z * xs[2] + g0.w * xs[3]) + (g1.x * xs[4] + g1.y * xs[5]) + (g1.z * xs[6] + g1.w * xs[7]);
        const float xt = hi ? xs[4 + r] : xs[r];
        const float yg = (y + Dh * xt) * silu_f(ZC[t * 256 + hh * 64 + p]);
        sq[r] = yg * yg;
        P_MIX[(size_t)(MP + b * 8 + t) * DM + h * 64 + p] = (bf16)(cvtpk(yg * nw, 0.f) & 0xffffu); }
#pragma unroll
    for (int o = 1; o < 32; o <<= 1) {
#pragma unroll
        for (int r = 0; r < 4; ++r) sq[r] += __shfl_xor(sq[r], o); }
    if (pl == 0) {
#pragma unroll
        for (int r = 0; r < 4; ++r) atomicAdd((float*)(SQL + 4 * hi + r), sq[r]); }
    {   const float e7 = Em[hh * 8 + 7]; float wx[8];
#pragma unroll
        for (int s2 = 0; s2 < 8; ++s2) wx[s2] = Wm[hh * 8 + s2] * xs[s2];
#pragma unroll
        for (int ks = 0; ks < 8; ++ks)
#pragma unroll
            for (int j = 0; j < 2; ++j) { f32x4 a = hk[ks][j] * e7;
#pragma unroll
                for (int s2 = 0; s2 < 8; ++s2) a += *(const LAS f32x4*)(BC + s2 * 128 + 16 * ks + 8 * hi + 4 * j) * wx[s2];
                *(f32x4*)(P_out + O_SSSM + sofs + 16 * ks + 4 * j) = a; } }
    STAMP(42);
    LBAR();
    if (F.tid < 8) atomicAdd(P_ssq + SSQ_REP_OFF + MP + b * 8 + F.tid, SQL[F.tid]);
}

#define WQ_LOOP(FR, ctr, N, CALL) do { unsigned nx_ = 0u; LBAR(); if ((FR).tid == 0) *slot = __hip_atomic_fetch_add((ctr), 1u, RLX_AGENT); LBAR(); \
        for (;;) { const int u = (int)*slot; if (u >= (int)(N)) break; if ((FR).tid == 0) nx_ = __hip_atomic_fetch_add((ctr), 1u, RLX_AGENT); \
            CALL; LBAR(); if ((FR).tid == 0) *slot = nx_; LBAR(); } } while (0)
__device__ __forceinline__ void p2_mixer(const Frame& F, const Ptrs& P, volatile LAS unsigned* slot, int rep) {
    {
        LAS float* TB = (LAS float*)(F.lds + TB_OFF);
        for (int i = F.tid; i < 16 * 128; i += 512) { const int hd = i >> 7, dist = i & 127; TB[i] = P_rel_bias[t5_bucket(dist) * 16 + hd] * LOG2E; }
    }
#ifndef MIX_MASK
#define MIX_MASK 15
#endif
    if (MIX_MASK & 1) for (;;) { const int u = wq_next(P_ctl + CW_Q + (0 + 4 * rep) * 64, slot, F.tid); if (u >= 128 * MIXDUP_A) break; ssd_prompt_unit(F, P, u / MIXDUP_A); } STAMP(20);
    if (MIX_MASK & 2) { WQ_LOOP(F, P_ctl + CW_Q + (1 + 4 * rep) * 64, 512 * MIXDUP_B, attn_prompt_unit(F, P, u / MIXDUP_B)); } STAMP(21);
    if (MIX_MASK & 4) { WQ_LOOP(F, P_ctl + CW_Q + (2 + 4 * rep) * 64, 512 * MIXDUP_C, attn_sample_unit(F, P, u / MIXDUP_C)); } STAMP(22);
    if (MIX_MASK & 8) { Frame F2 = F; asm volatile("" : "+v"(F2.tid), "+v"(F2.lane));
        WQ_LOOP(F2, P_ctl + CW_Q + (3 + 4 * rep) * 64, 1024 * MIXDUP_D, ssd_sample_unit(F2, P, u / MIXDUP_D)); } STAMP(23);
}

__device__ __forceinline__ void p3_ssd_norm(const Frame& F, const Ptrs& P) {
    const int gw = F.bid * NWAVES + F.wave, NGW = F.G * NWAVES;
    for (int m = gw; m < M; m += NGW) { const float rstd = 1.0f / sqrtf(P_ssq[m] * (1.0f / (2048.0f * (m < MP ? MIXDUP_A : MIXDUP_D))) + EPS); u32x4* mp = (u32x4*)(P_MIX + (size_t)m * DM + 2048) + F.lane;
#pragma unroll
        for (int j = 0; j < 4; ++j) { float f[8]; unpack8(mp[64 * j], f);
#pragma unroll
            for (int i = 0; i < 8; ++i) f[i] *= rstd;
            mp[64 * j] = pack8(f); } }
}
__device__ __forceinline__ size_t slab_off(int rs, int c, int kp) { return ((size_t)(((rs >> 8) * 16 + (c >> 8)) * 4 + kp)) * 65536 + (size_t)(rs & 255) * 256 + (c & 255); }
__device__ __forceinline__ void p5_sample_rows(const Frame& F, const Ptrs& P) {
    const int gw = F.bid * NWAVES + F.wave, NGW = F.G * NWAVES; const float* slab = (const float*)(P_ws + WS_SLAB);
    for (int rs = gw; rs < MS; rs += NGW) { float ss = 0.f; u32x2* o8 = (u32x2*)(P_X1B + (size_t)(MP + rs) * DM) + F.lane;
#pragma unroll 4
        for (int j = 0; j < 16; ++j) { const int c = 4 * (F.lane + 64 * j); f32x4 v = *(const f32x4*)(P_x_sample + (size_t)rs * DM + c);
#pragma unroll
            for (int kp = 0; kp < 4; ++kp) v += *(const f32x4*)(slab + slab_off(rs, c, kp));
            ss += (v.x * v.x + v.y * v.y) + (v.z * v.z + v.w * v.w);
            u32x2 o; o.x = cvtpk(v.x, v.y); o.y = cvtpk(v.z, v.w); o8[64 * j] = o; }
        ss = wave_sum(ss);
        if (F.lane == 0) P_ssq2[MP + rs] = ss;
    }
}
__device__ __forceinline__ void p9_final_reduce(const Frame& F, const Ptrs& P) {
    const int gw = F.bid * NWAVES + F.wave, NGW = F.G * NWAVES; const float* slab = (const float*)(P_ws + WS_SLAB);
    for (int rs = gw; rs < MS; rs += NGW) { const u32x2* x8 = (const u32x2*)(P_X1B + (size_t)(MP + rs) * DM) + F.lane;
#pragma unroll 4
        for (int j = 0; j < 16; ++j) { const int c = 4 * (F.lane + 64 * j); const u32x2 xw = x8[64 * j]; f32x4 v = (f32x4){bflo(xw.x), bfhi(xw.x), bflo(xw.y), bfhi(xw.y)};
#pragma unroll
            for (int kp = 0; kp < 4; ++kp) v += *(const f32x4*)(slab + slab_off(rs, c, kp));
            *(f32x4*)(P_out + (size_t)(MP + rs) * DM + c) = v; }
    }
}
__device__ __forceinline__ void p7_fix(const Frame& F, const Ptrs& P) {
    constexpr int NC4 = DFF / 4; const int ntask = 28 * NC4; const float* fix = (const float*)(P_ws + WS_FIX);
    for (int task = F.bid * 512 + F.tid; task < ntask; task += F.G * 512) {
        const int cc = task % NC4, pi = task / NC4, pm = 8 * (pi / 7) + 1 + (pi % 7), j = 4 * cc;
        const f32x4 h0 = *(const f32x4*)(fix + ((size_t)(pm - 1) * 2 + 0) * DFF + j), h1 = *(const f32x4*)(fix + ((size_t)(pm - 1) * 2 + 1) * DFF + j);
        const f32x4 g0 = *(const f32x4*)(fix + ((size_t)(72 + pm * 2 + 0)) * DFF + j), g1 = *(const f32x4*)(fix + ((size_t)(72 + pm * 2 + 1)) * DFF + j);
        const f32x4 u0 = *(const f32x4*)(fix + ((size_t)(144 + pm * 2 + 0)) * DFF + j), u1 = *(const f32x4*)(fix + ((size_t)(144 + pm * 2 + 1)) * DFF + j);
        const f32x4 w0 = *(const f32x4*)(P_fconv_w + j), w1 = *(const f32x4*)(P_fconv_w + DFF + j), w2 = *(const f32x4*)(P_fconv_w + 2 * DFF + j), bb = *(const f32x4*)(P_fconv_b + j);
        const f32x4 c0 = bb + w0 * h0 + w1 * h1 + w2 * g0, c1 = bb + w0 * h1 + w1 * g0 + w2 * g1;
        u32x2 a0, a1;
        a0.x = cvtpk(silu_f(c0.x) * u0.x, silu_f(c0.y) * u0.y); a0.y = cvtpk(silu_f(c0.z) * u0.z, silu_f(c0.w) * u0.w);
        a1.x = cvtpk(silu_f(c1.x) * u1.x, silu_f(c1.y) * u1.y); a1.y = cvtpk(silu_f(c1.z) * u1.z, silu_f(c1.w) * u1.w);
        *(u32x2*)(P_ACT + pg8::act_off(256 * pm, j)) = a0; *(u32x2*)(P_ACT + pg8::act_off(256 * pm + 1, j)) = a1;
    }
}

constexpr int TAIL_NT = 24;
__device__ __forceinline__ void p8_tail_reduce(const Frame& F, const Ptrs& P) {
    const float* slab = (const float*)(P_ws + WS_SLAB); const int ntask = TAIL_NT * 32 * 4; const int gw = F.bid * NWAVES + F.wave, NGW = F.G * NWAVES;
    for (int task = gw; task < ntask; task += NGW) {
        const int c8 = task & 3, sq = (task >> 2) & 31, t = task >> 7, tt = F.lane >> 3, cq = c8 * 8 + (F.lane & 7);
        const int j = (80 + (t >> 2)) * 128 + 4 * cq, r = (32 + (t & 3)) * 256 + 8 * sq + tt, bs = (r - MP) >> 3;
        const float* sp = slab + (size_t)(t * 8) * 65536 + (size_t)(8 * sq + tt) * 256 + 4 * cq;
        f32x4 g = (f32x4){0.f, 0.f, 0.f, 0.f}, uu = g;
#pragma unroll
        for (int kp = 0; kp < 8; ++kp) { g += *(const f32x4*)(sp + (size_t)kp * 65536); uu += *(const f32x4*)(sp + (size_t)kp * 65536 + 128); }
        const float rs = 1.0f / sqrtf(P_ssq2[r] * (1.0f / DM) + EPS); g *= rs; uu *= rs;
        const f32x4 w0 = *(const f32x4*)(P_fconv_w + j), w1 = *(const f32x4*)(P_fconv_w + DFF + j), w2 = *(const f32x4*)(P_fconv_w + 2 * DFF + j), bb = *(const f32x4*)(P_fconv_b + j);
        const f32x4 s0 = *(const f32x4*)(P_st_ffn + ((size_t)bs * 2 + 0) * DFF + j), s1 = *(const f32x4*)(P_st_ffn + ((size_t)bs * 2 + 1) * DFF + j);
        f32x4 p1, p2;
#pragma unroll
        for (int e = 0; e < 4; ++e) { const float a1 = __shfl_up(g[e], 8), a2 = __shfl_up(g[e], 16); p1[e] = (tt >= 1) ? a1 : s1[e]; p2[e] = (tt >= 2) ? a2 : (tt == 1 ? s1[e] : s0[e]); }
        const f32x4 gc = bb + w0 * p2 + w1 * p1 + w2 * g;
        u32x2 a; a.x = cvtpk(silu_f(gc.x) * uu.x, silu_f(gc.y) * uu.y); a.y = cvtpk(silu_f(gc.z) * uu.z, silu_f(gc.w) * uu.w);
        *(u32x2*)(P_ACT + pg8::act_off(r, j)) = a;
        if (tt >= 6) *(f32x4*)(P_out + O_SFFN + ((size_t)bs * 2 + (tt - 6)) * DFF + j) = g;
    }
}

__global__ void __launch_bounds__(NWAVES * 64, 2) hymba_fwd(Args args) {
    extern __shared__ __attribute__((aligned(16))) unsigned char lds_raw[];
    Frame F; F.lds = (LAS unsigned char*)lds_raw; F.tid = threadIdx.x; F.lane = F.tid & 63; F.wave = __builtin_amdgcn_readfirstlane(F.tid >> 6); F.G = KARG->grid; F.bid = blockIdx.x;
    volatile LAS unsigned* MISC = (volatile LAS unsigned*)(F.lds + MISC_OFF);
    Ptrs P;
    for (int u = F.tid; u < (LDS_BYTES - LDSCTL_OFF) / 4; u += NWAVES * 64) ((LAS unsigned*)(F.lds + LDSCTL_OFF))[u] = 0u;
    __syncthreads();
    if (N_LAUNCHES == 1) (void)xcd_barrier_post((unsigned*)(P_ctl + CW_BAR), MISC + 8);
    const int lo = KARG->ph_lo, hi = KARG->ph_hi;
    STAMP(0);
#ifndef PHASE_MASK
#define PHASE_MASK 0x7ff
#endif
#define IN(k) ((((PHASE_MASK) >> (k)) & 1) && lo <= (k) && (k) < hi)
#define SEAM(k) do { if (IN(k) && IN((k) + 1)) { XcdBarrier b_; b_.bar = (unsigned*)(P_ctl + CW_BAR); b_.x = xb_xcc_id(); b_.st = MISC + 8; xcd_barrier(b_); } } while (0)

    if (IN(0)) { for (int rep = 0; rep < NREP_P0; ++rep) p0_prologue(F, P); } SEAM(0); STAMP(1);
    if (IN(1)) {
        pg8::Gemm g{P_XN, P_W1, M, LDP, DM}; pg8::Gemm1BlockOrder S{F.G, F.bid, DM / 64};
        pg8::EpiStoreBf16 E{P_PROJ, LDP};
        pg8::gemm_phase<pg8::EpiStoreBf16, pg8::Gemm1BlockOrder, PG8_ALIGN, PG8_SP2>(F.lds + RING_OFF, g, S, E);
        convert_weights_dyn<3>(F, P_ctl + CW_Q + 9 * 64);
    } SEAM(1); STAMP(2);
    if (IN(2)) { p2_conv_pass(F, P); } SEAM(2); STAMP(3);
    if (IN(3)) { for (int rep = NREP_MIX - 1; rep >= 0; --rep) { if (F.tid == 0) MISC[5] = (unsigned)(rep * M); __syncthreads(); p2_mixer(F, P, MISC + 4, rep); } } SEAM(3); STAMP(4);
    if (IN(5)) {
        pg8::Gemm g{P_MIX, P_W2, M, DM, DM};
        { pg8::ChainOrder S; S.S0.init(MP, DM, F.G, F.bid, DM); S.ntA = 32; S.ntB = 32; pg8::EpiResBf16Ssq E{P_x_prompt, P_X1B, P_ssq2, DM, P_ssq};
          pg8::gemm_phase<pg8::EpiResBf16Ssq, pg8::ChainOrder, PG8_ALIGN, PG8_SP2>(F.lds + RING_OFF, g, S, E); }
        { pg8::PieceOrder S{F.G, F.bid, MP / 256, DM / 256, 4 * (MS / 256) * (DM / 256), 16, 16}; pg8::EpiSlab E{(float*)(P_ws + WS_SLAB), P_ssq, 32};
          pg8::gemm_phase<pg8::EpiSlab, pg8::PieceOrder, PG8_ALIGN, PG8_SP2>(F.lds + RING_OFF, g, S, E); }
    } SEAM(5); STAMP(6);
    if (IN(6)) { p5_sample_rows(F, P); } SEAM(6); STAMP(7);
    if (IN(7)) {
        pg8::Gemm g{P_X1B, P_W3, M, NGU, DM};
        pg8::EpiGateUp E{P_ACT, P_fconv_w, P_fconv_b, P_st_ffn, (float*)(P_ws + WS_FIX), P_out, (LAS float*)(F.lds + CWL_OFF), P_ssq2};
        { pg8::Gemm3BlockOrder S{F.G, F.bid, DM / 64};
          pg8::gemm_phase<pg8::EpiGateUp, pg8::Gemm3BlockOrder, true, PG8_SP2>(F.lds + RING_OFF, g, S, E); }
        { pg8::TailPieceOrder S{F.G, F.bid, TAIL_NT * 8}; pg8::EpiSlabPerm E2{(float*)(P_ws + WS_SLAB)};
          STAMP(50);
          pg8::gemm_phase<pg8::EpiSlabPerm, pg8::TailPieceOrder, PG8_ALIGN, PG8_SP2>(F.lds + RING_OFF, g, S, E2); }
        STAMP(51);
        convert_weights_dyn<4>(F, P_ctl + CW_Q + 10 * 64);
    } SEAM(7); STAMP(8);
    if (IN(8)) { p7_fix(F, P); p8_tail_reduce(F, P); } SEAM(8); STAMP(9);
    if (IN(9)) {
        pg8::Gemm g{P_ACT, P_W4, M, DM, DFF};
        { pg8::HalfMOrder S{F.G, F.bid, DFF / 64}; pg8::EpiResFromBf16 E{P_X1B, P_out, DM};
          pg8::gemm_phase<pg8::EpiResFromBf16, pg8::HalfMOrder, PG8_ALIGN, PG8_SP2, true>(F.lds + RING_OFF, g, S, E); }
        { pg8::PieceOrder S{F.G, F.bid, MP / 256, DM / 256, 4 * (MS / 256) * (DM / 256), 44, 42}; pg8::EpiSlab E{(float*)(P_ws + WS_SLAB), nullptr, 0};
          pg8::gemm_phase<pg8::EpiSlab, pg8::PieceOrder, PG8_ALIGN, PG8_SP2, true>(F.lds + RING_OFF, g, S, E); }
    } SEAM(9); STAMP(10);
    if (IN(10)) { p9_final_reduce(F, P); }
    STAMP(11);
#ifdef PROBE_A
    if (F.bid == PROBE_BID && F.tid == 0) { volatile LAS unsigned* m_ = (volatile LAS unsigned*)(F.lds + MISC_OFF) + 16; const unsigned long long a_ = ((unsigned long long)m_[1] << 32) | m_[0], b_ = ((unsigned long long)m_[3] << 32) | m_[2];
        const unsigned long long d_ = (b_ - a_) * PROBE_MULT, s0_ = __builtin_amdgcn_s_memrealtime(); while (__builtin_amdgcn_s_memrealtime() - s0_ < d_) __builtin_amdgcn_s_sleep(8); }
#endif
#undef IN
#undef SEAM
}

extern "C" void kernel_launch(void* const* d_in, const int* in_sizes, int n_in, void* d_out, int out_size, void* d_ws, size_t ws_size, hipStream_t stream) {
    static int grid = 0;
    if (grid == 0) {
        if (n_in != 26 || (size_t)out_size != O_END || ws_size < WS_END) { fprintf(stderr, "kernel_launch: unexpected shapes: n_in %d out %d ws %zu (need %zu); nothing launched\n", n_in, out_size, ws_size, (size_t)WS_END); grid = -1; return; }
        int dev = 0, cus = 0, per_cu = 0;
        if (hipGetDevice(&dev) != hipSuccess || hipDeviceGetAttribute(&cus, hipDeviceAttributeMultiprocessorCount, dev) != hipSuccess) { grid = -1; return; }
        if (hipFuncSetAttribute((const void*)hymba_fwd, hipFuncAttributeMaxDynamicSharedMemorySize, LDS_BYTES) != hipSuccess) { fprintf(stderr, "kernel_launch: hipFuncSetAttribute failed\n"); grid = -1; return; }
        if (hipOccupancyMaxActiveBlocksPerMultiprocessor(&per_cu, (const void*)hymba_fwd, NWAVES * 64, LDS_BYTES) != hipSuccess || per_cu < 1) { fprintf(stderr, "kernel_launch: occupancy query reports %d blocks per CU\n", per_cu); }
        (void)hipGetLastError();
        grid = cus;
    }
    if (grid < 0) return;
    if (hipMemsetAsync((char*)d_ws + WS_CTL, 0, CTL_ZERO_BYTES, stream) != hipSuccess) return;
    Args a{};
    for (int i = 0; i < 26; ++i) a.in[i] = (const float*)d_in[i];
    a.out = (float*)d_out; a.ws = (unsigned char*)d_ws; a.grid = grid; a.pad = 0;
    if (N_LAUNCHES == 1) { a.ph_lo = 0; a.ph_hi = N_PHASES; hipLaunchKernelGGL(hymba_fwd, dim3(grid), dim3(NWAVES * 64), LDS_BYTES, stream, a); }
    else { for (int li = 0; li < N_PHASES; ++li) { a.ph_lo = li; a.ph_hi = li + 1; hipLaunchKernelGGL(hymba_fwd, dim3(grid), dim3(NWAVES * 64), LDS_BYTES, stream, a); } }
}
```
